# Optimizing an MI355X kernel written in HIP

```python
import jax, jax.numpy as jnp
from jax import lax
import numpy as np

D_MODEL = 2048
BATCH = 4
SEQ = 2048
DEPTH = 1
DEC_BATCH = 8
DEC_SEQ = 32
PAST_LEN = 2048

CHUNK = 64
MIX_WIDTH = D_MODEL
SB_WIDTH = MIX_WIDTH // 2
SB_HEAD_DIM = 128
SB_HEADS = SB_WIDTH // SB_HEAD_DIM
POOL_WIDTH = MIX_WIDTH - SB_WIDTH
POOL_WINDOWS = (2, 4, 8, 16)
POOL_GROUPS = len(POOL_WINDOWS)
POOL_GROUP_DIM = POOL_WIDTH // POOL_GROUPS
POOL_STATE = max(POOL_WINDOWS) - 1
IN_WIDTH = 3 * SB_WIDTH + POOL_WIDTH
D_FF = 5632
PLE_DIM = 256
Q_BLOCK = 128
RMS_EPS = 1e-6
SB_SCALE = SB_HEAD_DIM ** -0.5

kernel_name = "hymba_stickbreak_pool_macaron_stream_step"


def _rmsnorm(x, g):
    xf = x.astype(jnp.float32)
    r = lax.rsqrt(jnp.mean(xf * xf, axis=-1, keepdims=True) + RMS_EPS)
    return (xf * r * g.astype(jnp.float32)).astype(x.dtype)


def _swiglu(x, w_gate, w_up, w_down):
    return (jax.nn.silu(x @ w_gate) * (x @ w_up)) @ w_down


def _sb_block(qb, qpos, k, v, kpos):
    z = jnp.einsum('bqhd,bkhd->bhqk', qb, k).astype(jnp.float32) * SB_SCALE
    mask = kpos[None, :] < qpos[:, None]
    log_beta = jax.nn.log_sigmoid(z)
    log_rest = jnp.where(mask, log_beta - z, 0.0)
    suffix = lax.cumsum(log_rest, axis=3, reverse=True) - log_rest
    a = jnp.where(mask, jnp.exp(log_beta + suffix), 0.0)
    return jnp.einsum('bhqk,bkhd->bqhd', a, v.astype(jnp.float32))


def _stick_breaking(q, k, v, qpos, kpos):
    b, t, h, d = q.shape
    if t <= Q_BLOCK:
        return _sb_block(q, qpos, k, v, kpos)
    nb = t // Q_BLOCK
    qb = q.reshape(b, nb, Q_BLOCK, h, d).transpose(1, 0, 2, 3, 4)
    pb = qpos.reshape(nb, Q_BLOCK)
    out = lax.map(lambda args: _sb_block(args[0], args[1], k, v, kpos), (qb, pb))
    return out.transpose(1, 0, 2, 3, 4).reshape(b, t, h, d)


def _multiscale_pool(xp, pool_past, pos, w_pool):
    b, t, _ = xp.shape
    full = jnp.concatenate([pool_past.astype(xp.dtype), xp], axis=1)
    ff = full.astype(jnp.float32)
    csum = jnp.concatenate([jnp.zeros((b, 1, POOL_WIDTH), jnp.float32), jnp.cumsum(ff, axis=1)], axis=1)
    xf = xp.astype(jnp.float32)
    outs = []
    for g, w in enumerate(POOL_WINDOWS):
        sl = slice(g * POOL_GROUP_DIM, (g + 1) * POOL_GROUP_DIM)
        cg = csum[:, :, sl]
        win = cg[:, POOL_STATE + 1:POOL_STATE + 1 + t] - cg[:, POOL_STATE + 1 - w:POOL_STATE + 1 - w + t]
        cnt = jnp.minimum(pos + 1, w).astype(jnp.float32)
        outs.append(win / cnt[None, :, None] - xf[:, :, sl])
    pooled = jnp.stack(outs, axis=2)
    mixed = jnp.einsum('btgc,gcd->btgd', pooled, w_pool.astype(jnp.float32))
    return mixed.reshape(b, t, POOL_WIDTH).astype(xp.dtype), full[:, -POOL_STATE:]


def _layer(x, p, pos, k_past, v_past, pool_past, g_ffn1, w1_gate, w1_up, w1_down, g_mix, w_in,
           g_attn_out, w_pool, pool_scale, w_out, g_ffn2, w2_gate, w2_up, w2_down,
           g_ple, w_ple_gate, w_ple_proj):
    b, t, _ = x.shape
    h = x + 0.5 * _swiglu(_rmsnorm(x, g_ffn1), w1_gate, w1_up, w1_down)
    u = _rmsnorm(h, g_mix)
    z = u @ w_in
    q, k, v, xp = jnp.split(z, [SB_WIDTH, 2 * SB_WIDTH, 3 * SB_WIDTH], axis=-1)
    q = q.reshape(b, t, SB_HEADS, SB_HEAD_DIM)
    k = k.reshape(b, t, SB_HEADS, SB_HEAD_DIM)
    v = v.reshape(b, t, SB_HEADS, SB_HEAD_DIM)
    if k_past is None:
        k_all, v_all = k, v
    else:
        k_all = jnp.concatenate([k_past.astype(k.dtype), k], axis=1)
        v_all = jnp.concatenate([v_past.astype(v.dtype), v], axis=1)
    kpos = jnp.arange(k_all.shape[1], dtype=jnp.int32)
    attn = _stick_breaking(q, k_all, v_all, pos, kpos).reshape(b, t, SB_WIDTH)
    attn = _rmsnorm(attn.astype(x.dtype), g_attn_out)
    if pool_past is None:
        pool_past = jnp.zeros((b, POOL_STATE, POOL_WIDTH), xp.dtype)
    pooled, new_pool = _multiscale_pool(xp, pool_past, pos, w_pool)
    pooled = _rmsnorm(pooled, pool_scale)
    h = h + jnp.concatenate([attn, pooled], axis=-1) @ w_out
    h = h + 0.5 * _swiglu(_rmsnorm(h, g_ffn2), w2_gate, w2_up, w2_down)
    gate = jax.nn.sigmoid((_rmsnorm(h, g_ple) @ w_ple_gate).astype(jnp.float32))
    h = h + (gate * (p @ w_ple_proj).astype(jnp.float32)).astype(h.dtype)
    return h, k, v, new_pool


def setup_inputs(seed: int = 0) -> dict:
    key = jax.random.key(seed)
    ks = jax.random.split(key, 28)
    f32 = jnp.float32

    def nrm(k, shape, scale):
        return jax.random.normal(k, shape, f32) * scale

    def gain(k, shape):
        return 1.0 + 0.1 * jax.random.normal(k, shape, f32)

    D = D_MODEL
    return {
        "x_prompt": nrm(ks[0], (BATCH, SEQ, D), 1.0),
        "x_sample": nrm(ks[1], (DEC_BATCH, DEC_SEQ, D), 1.0),
        "cache_k": nrm(ks[2], (DEPTH, DEC_BATCH, PAST_LEN, SB_HEADS, SB_HEAD_DIM), 1.0),
        "cache_v": nrm(ks[3], (DEPTH, DEC_BATCH, PAST_LEN, SB_HEADS, SB_HEAD_DIM), 1.0),
        "state_pool": nrm(ks[4], (DEPTH, DEC_BATCH, POOL_STATE, POOL_WIDTH), 1.0),
        "p_prompt": nrm(ks[5], (DEPTH, BATCH, SEQ, PLE_DIM), 1.0),
        "p_sample": nrm(ks[6], (DEPTH, DEC_BATCH, DEC_SEQ, PLE_DIM), 1.0),
        "g_ffn1": gain(ks[7], (DEPTH, D)),
        "w1_gate": nrm(ks[8], (DEPTH, D, D_FF), D ** -0.5),
        "w1_up": nrm(ks[9], (DEPTH, D, D_FF), D ** -0.5),
        "w1_down": nrm(ks[10], (DEPTH, D_FF, D), D_FF ** -0.5),
        "g_mix": gain(ks[11], (DEPTH, D)),
        "w_in": nrm(ks[12], (DEPTH, D, IN_WIDTH), D ** -0.5),
        "g_attn_out": gain(ks[13], (DEPTH, SB_WIDTH)),
        "w_pool": nrm(ks[14], (DEPTH, POOL_GROUPS, POOL_GROUP_DIM, POOL_GROUP_DIM), POOL_GROUP_DIM ** -0.5),
        "pool_scale": gain(ks[15], (DEPTH, POOL_WIDTH)),
        "w_out": nrm(ks[16], (DEPTH, MIX_WIDTH, D), MIX_WIDTH ** -0.5),
        "g_ffn2": gain(ks[17], (DEPTH, D)),
        "w2_gate": nrm(ks[18], (DEPTH, D, D_FF), D ** -0.5),
        "w2_up": nrm(ks[19], (DEPTH, D, D_FF), D ** -0.5),
        "w2_down": nrm(ks[20], (DEPTH, D_FF, D), D_FF ** -0.5),
        "g_ple": gain(ks[21], (DEPTH, D)),
        "w_ple_gate": nrm(ks[22], (DEPTH, D, D), D ** -0.5),
        "w_ple_proj": nrm(ks[23], (DEPTH, PLE_DIM, D), PLE_DIM ** -0.5),
        "g_final": gain(ks[24], (D,)),
    }


def reference(x_prompt, x_sample, cache_k, cache_v, state_pool, p_prompt, p_sample,
              g_ffn1, w1_gate, w1_up, w1_down, g_mix, w_in, g_attn_out, w_pool, pool_scale,
              w_out, g_ffn2, w2_gate, w2_up, w2_down, g_ple, w_ple_gate, w_ple_proj, g_final):
    t_p = x_prompt.shape[1]
    t_s = x_sample.shape[1]
    past = cache_k.shape[2]
    pos_p = jnp.arange(t_p, dtype=jnp.int32)
    pos_s = past + jnp.arange(t_s, dtype=jnp.int32)
    hp, hs = x_prompt, x_sample
    kp_l, vp_l, sp_l, ks_l, vs_l, ss_l = [], [], [], [], [], []
    for i in range(DEPTH):
        wts = (g_ffn1[i], w1_gate[i], w1_up[i], w1_down[i], g_mix[i], w_in[i], g_attn_out[i],
               w_pool[i], pool_scale[i], w_out[i], g_ffn2[i], w2_gate[i], w2_up[i], w2_down[i],
               g_ple[i], w_ple_gate[i], w_ple_proj[i])
        hp, kp, vp, sp = _layer(hp, p_prompt[i], pos_p, None, None, None, *wts)
        hs, ks_, vs_, ss = _layer(hs, p_sample[i], pos_s, cache_k[i], cache_v[i], state_pool[i], *wts)
        kp_l.append(kp); vp_l.append(vp); sp_l.append(sp)
        ks_l.append(ks_); vs_l.append(vs_); ss_l.append(ss)
    y_prompt = _rmsnorm(hp, g_final)
    y_sample = _rmsnorm(hs, g_final)
    new_k_prompt = jnp.stack(kp_l)
    new_v_prompt = jnp.stack(vp_l)
    new_pool_prompt = jnp.stack(sp_l)
    new_k_sample = jnp.stack(ks_l)
    new_v_sample = jnp.stack(vs_l)
    new_pool_sample = jnp.stack(ss_l)
    return (y_prompt, y_sample, new_k_prompt, new_v_prompt, new_pool_prompt, new_k_sample, new_v_sample, new_pool_sample)
```

```cpp
#include <hip/hip_runtime.h>
#include <cstdio>
#include <cstdint>

#ifndef MK_N_LAUNCHES
#define MK_N_LAUNCHES 1
#endif
#ifndef FORCE_GRID_SEAMS
#define FORCE_GRID_SEAMS 0
#endif

constexpr int DM = 2048, FF = 5632, NCAT = 2 * FF, NIN = 4096, SBW = 1024, PWID = 1024, PLE = 256;
constexpr int BATCH = 4, SEQ = 2048, DECB = 8, DECS = 32, PAST = 2048, NH = 8, HD = 128, PSTATE = 15;
constexpr int MP = BATCH * SEQ, MS = DECB * DECS, M = MP + MS;
constexpr float RMS_EPS = 1e-6f;
constexpr float LOG2E = 1.4426950408889634f;
constexpr float QSCALE = 0.08838834764831845f * LOG2E;
constexpr size_t OFF_Y = 0;
constexpr size_t OFF_KP = (size_t)M * DM;
constexpr size_t OFF_VP = OFF_KP + (size_t)MP * SBW;
constexpr size_t OFF_PP = OFF_VP + (size_t)MP * SBW;
constexpr size_t OFF_KS = OFF_PP + (size_t)BATCH * PSTATE * PWID;
constexpr size_t OFF_VS = OFF_KS + (size_t)MS * SBW;
constexpr size_t OFF_PS = OFF_VS + (size_t)MS * SBW;
constexpr size_t OUT_TOTAL = OFF_PS + (size_t)DECB * PSTATE * PWID;

namespace pg8 {
#define PG8_LAS __attribute__((address_space(3)))
typedef unsigned short bf16_t;
typedef short bf16x8 __attribute__((ext_vector_type(8)));
typedef float f32x4 __attribute__((ext_vector_type(4)));
typedef unsigned u32x4 __attribute__((ext_vector_type(4)));
typedef unsigned u32x2 __attribute__((ext_vector_type(2)));
constexpr int BM = 256, BK = 64, HALF = 128, HTB = HALF * BK * 2, STAGE_BYTES = 8 * HTB, NXCD = 8, WGM = 4;

__host__ __device__ __forceinline__ int lds_byte(int r, int c) { const int st = (r >> 4) * 2 + (c >> 5), rr = r & 15, cc = c & 31, ob = rr * 64 + cc * 2; return st * 1024 + (ob ^ (((ob >> 9) & 1) << 5)); }
__host__ __device__ __forceinline__ void stage_rc(int b, int& R, int& C) { const int st = b / 1024, sb = b % 1024, swz = sb ^ (((sb >> 9) & 1) << 5); R = (st >> 1) * 16 + swz / 64; C = (st & 1) * 32 + (swz % 64) / 2; }

struct Unit { int pm, pn, kt0, nkt, part; };
struct Gemm { const bf16_t* A; const bf16_t* Bt; int M, N, K, lda, ldb, a_pn_off; };

__host__ __device__ __forceinline__ void tile_of(int wgid_in, int nwg, int nM, int nN, int& pm, int& pn) {
    int wgid = wgid_in; { const int q = nwg / NXCD, r = nwg % NXCD, xcd = wgid % NXCD, off = wgid / NXCD; wgid = (xcd < r ? xcd * (q + 1) : r * (q + 1) + (xcd - r) * q) + off; }
    const int nig = WGM * nN, gid = wgid / nig, fm = gid * WGM, gsz = (nM - fm) < WGM ? (nM - fm) : WGM;
    pm = fm + ((wgid % nig) % gsz); pn = (wgid % nig) / gsz;
}
struct StaticOrder {
    int nM, nN, nwg, G, c, NT;
    __host__ __device__ __forceinline__ void init(int M, int N, int K, int G_, int c_) { nM = M / BM; nN = N / BM; nwg = nM * nN; G = G_; c = c_; NT = K / BK; }
    __host__ __device__ __forceinline__ bool next(int i, Unit& u) const {
        const long L = (long)i * G + c; const bool ok = L < nwg; int pm = 0, pn = 0;
        if (ok) tile_of((int)L, nwg, nM, nN, pm, pn);
        u.pm = pm; u.pn = pn; u.kt0 = 0; u.nkt = NT; u.part = 0; return ok;
    }
    __device__ __forceinline__ void a_ready(const Unit&) const {}
    __device__ __forceinline__ void done(const Unit&) const {}
};
struct HalvesOrder {
    int nM, nN, nwg, G, c, NT;
    __host__ __device__ __forceinline__ void init(int M, int N, int K, int G_, int c_) { nM = M / BM; nN = N / BM; nwg = nM * nN; G = G_; c = c_; NT = K / BK; }
    __host__ __device__ __forceinline__ bool next(int i, Unit& u) const {
        const long L = (long)(i >> 1) * G + c; const bool ok = L < nwg; int pm = 0, pn = 0;
        if (ok) tile_of((int)L, nwg, nM, nN, pm, pn);
        const int nkt = NT >> 1;
        u.pm = pm; u.pn = pn; u.kt0 = (i & 1) * nkt; u.nkt = nkt; u.part = (i & 1) ? 0 : 2; return ok;
    }
    __device__ __forceinline__ void a_ready(const Unit&) const {}
    __device__ __forceinline__ void done(const Unit&) const {}
};
template <bool HALVES> struct OneTileT {
    int pm, pn, NT, on;
    __host__ __device__ __forceinline__ bool next(int i, Unit& u) const {
        const int nkt = HALVES ? (NT >> 1) : NT;
        u.pm = pm; u.pn = pn; u.kt0 = HALVES ? (i & 1) * nkt : 0; u.nkt = nkt; u.part = HALVES ? ((i & 1) ? 0 : 2) : 0;
        return on > i * (HALVES ? 1 : 2);
    }
    __device__ __forceinline__ void a_ready(const Unit&) const {}
    __device__ __forceinline__ void done(const Unit&) const {}
};
typedef OneTileT<false> OneTile; typedef OneTileT<true> OneTileH;
struct OnePiece {
    int pm, pn, kt0, nkt, on;
    __host__ __device__ __forceinline__ bool next(int i, Unit& u) const { u.pm = pm; u.pn = pn; u.kt0 = kt0; u.nkt = nkt; u.part = 0; return on > i * 2; }
    __device__ __forceinline__ void a_ready(const Unit&) const {}
    __device__ __forceinline__ void done(const Unit&) const {}
};
struct SkewOrder {
    int nM, nN, nwg, chunk, x, j, r0, r1, NT; int lo[6], hi[6];
    __host__ __device__ __forceinline__ void init(int M, int N, int K, int G, int c, int r0_, int r1_) { nM = M / BM; nN = N / BM; nwg = nM * nN; chunk = nwg / NXCD; x = c % NXCD; j = c / NXCD; r0 = r0_; r1 = r1_; NT = K / BK; (void)G;
#pragma unroll
        for (int r = 0; r < 6; ++r) hi[r] = 32; }
    __host__ __device__ __forceinline__ bool next(int i, Unit& u) const {
        int pre = 0, k = 0, off = -1;
#pragma unroll
        for (int r = 0; r < 6; ++r) { const bool act = j >= lo[r] && j < hi[r]; if (act && r >= r0 && r < r1) { if (k == i) off = pre + (j - lo[r]); ++k; } pre += hi[r] - lo[r]; }
        const bool ok = off >= 0 && off < chunk; int pm = 0, pn = 0;
        if (ok) { const int wgid = x * chunk + off; const int nig = WGM * nN, gid = wgid / nig, fm = gid * WGM, gsz = (nM - fm) < WGM ? (nM - fm) : WGM; pm = fm + ((wgid % nig) % gsz); pn = (wgid % nig) / gsz; }
        u.pm = pm; u.pn = pn; u.kt0 = 0; u.nkt = NT; u.part = 0; return ok;
    }
    __device__ __forceinline__ void a_ready(const Unit&) const {}
    __device__ __forceinline__ void done(const Unit&) const {}
};
typedef float f32x2 __attribute__((ext_vector_type(2)));
typedef __bf16 bf16x2_t __attribute__((ext_vector_type(2)));
__device__ __forceinline__ unsigned pk2(float lo, float hi) { f32x2 v = {lo, hi}; bf16x2_t b = __builtin_convertvector(v, bf16x2_t); return __builtin_bit_cast(unsigned, b); }
__device__ __forceinline__ u32x2 pk4(f32x4 v) { u32x2 w; w.x = pk2(v[0], v[1]); w.y = pk2(v[2], v[3]); return w; }
__device__ __forceinline__ float bf_lo(unsigned w) { return __uint_as_float(w << 16); }
__device__ __forceinline__ float bf_hi(unsigned w) { return __uint_as_float(w & 0xffff0000u); }
__device__ __forceinline__ float rs_of(float ssq, float inv_w) { return __builtin_amdgcn_rsqf(ssq * inv_w + RMS_EPS); }
__device__ __forceinline__ float sigmoidf_(float g) { return __builtin_amdgcn_rcpf(1.0f + __builtin_amdgcn_exp2f(-g * LOG2E)); }
__device__ __forceinline__ float dot4(f32x4 v) { return (v[0] * v[0] + v[1] * v[1]) + (v[2] * v[2] + v[3] * v[3]); }

__device__ __forceinline__ void row_scales(const float* ssq, float inv_w, int row0, float (&rsv)[2][4]) {
    float q[2][4];
#pragma unroll
    for (int ai = 0; ai < 2; ++ai)
#pragma unroll
        for (int m = 0; m < 4; ++m) q[ai][m] = ssq[row0 + ai * HALF + m * 16];
#pragma unroll
    for (int ai = 0; ai < 2; ++ai)
#pragma unroll
        for (int m = 0; m < 4; ++m) rsv[ai][m] = rs_of(q[ai][m], inv_w);
}

struct AccSrc { const f32x4 (&acc)[2][2][4][2]; __device__ __forceinline__ f32x4 operator()(int ai, int bj, int m, int n) const { return acc[ai][bj][m][n]; } };
struct EpiSwiGLU {
    static constexpr bool AFTER_DRAIN = false, MID = false, FINAL = false;
    bf16_t* G; const float* ssq; float inv_w;
    template <class Src> __device__ __forceinline__ void run(const Src& src, const Unit& u, int wr, int wc, int fr, int fq) const {
        const int row0 = u.pm * BM + wr * 64 + fr, col0 = u.pn * HALF + wc * 32 + 4 * fq;
        float rsv[2][4]; row_scales(ssq, inv_w, row0, rsv);
#pragma unroll
        for (int ai = 0; ai < 2; ++ai)
#pragma unroll
            for (int m = 0; m < 4; ++m) { const int row = row0 + ai * HALF + m * 16; const float r = rsv[ai][m]; bf16_t* rowp = G + (size_t)row * FF + col0;
#pragma unroll
                for (int n = 0; n < 2; ++n) { const f32x4 g = src(ai, 0, m, n) * r, up = src(ai, 1, m, n) * r; f32x4 v;
#pragma unroll
                    for (int i = 0; i < 4; ++i) v[i] = g[i] * sigmoidf_(g[i]) * up[i];
                    *(u32x2*)(rowp + n * 16) = pk4(v); }
                if (m & 1) asm volatile("" ::: "memory"); }
    }
};
struct EpiBf {
    static constexpr bool AFTER_DRAIN = false, MID = false, FINAL = false;
    bf16_t* O; int ldc, col_base; float* ssq_out;
    template <class Src> __device__ __forceinline__ void run(const Src& src, const Unit& u, int wr, int wc, int fr, int fq) const {
        const int row0 = u.pm * BM + wr * 64 + fr, col0 = col_base + u.pn * BM + wc * 32 + 4 * fq;
#pragma unroll
        for (int ai = 0; ai < 2; ++ai)
#pragma unroll
            for (int m = 0; m < 4; ++m) { const int row = row0 + ai * HALF + m * 16; bf16_t* rowp = O + (size_t)row * ldc + col0; float s = 0.f;
#pragma unroll
                for (int bj = 0; bj < 2; ++bj)
#pragma unroll
                    for (int n = 0; n < 2; ++n) { const f32x4 v = src(ai, bj, m, n); *(u32x2*)(rowp + bj * HALF + n * 16) = pk4(v); s += dot4(v); }
                if (ssq_out) { s += __shfl_xor(s, 16); s += __shfl_xor(s, 32); if (fq == 0) atomicAdd(ssq_out + row, s); }
                if (m & 1) asm volatile("" ::: "memory"); }
    }
};
struct EpiRaw {
    static constexpr bool AFTER_DRAIN = false, MID = false, FINAL = false;
    float* slab;
    template <class Src> __device__ __forceinline__ void run(const Src& src, const Unit& u, int wr, int wc, int fr, int fq) const {
        float* t = slab + (size_t)u.pn * 65536 + (size_t)(wr * 64 + fr) * 256 + wc * 32 + 4 * fq;
#pragma unroll
        for (int ai = 0; ai < 2; ++ai)
#pragma unroll
            for (int m = 0; m < 4; ++m)
#pragma unroll
                for (int bj = 0; bj < 2; ++bj)
#pragma unroll
                    for (int n = 0; n < 2; ++n) *(f32x4*)(t + (ai * HALF + m * 16) * 256 + bj * HALF + n * 16) = src(ai, bj, m, n);
    }
};
template <bool HAS_MID, bool BASE_BF16, bool ADD_SLAB = false, bool PRE_SCALE = false> struct EpiRes {
    static constexpr bool AFTER_DRAIN = false, MID = HAS_MID, FINAL = false;
    const float* base0; const float* base1;
    const bf16_t* baseb; bf16_t* outb; float* ssq_out;
    const float* ssq_rs; float inv_w_rs, alpha;
    const float* ssq_a; const float* ssq_p; float inv_w_mid;
    const float* slab; unsigned* flag; unsigned* tmo;
    __device__ __forceinline__ float midf(int row) const { return __builtin_amdgcn_sqrtf((ssq_p[row] * inv_w_mid + RMS_EPS) * __builtin_amdgcn_rcpf(ssq_a[row] * inv_w_mid + RMS_EPS)); }
    __device__ __forceinline__ void mid(f32x4 (&acc)[2][2][4][2], const Unit& u, int wr, int wc, int fr, int fq) const {
        const int row0 = u.pm * BM + wr * 64 + fr;
        float qa[2][4], qp[2][4];
#pragma unroll
        for (int ai = 0; ai < 2; ++ai)
#pragma unroll
            for (int m = 0; m < 4; ++m) { const int row = row0 + ai * HALF + m * 16; qa[ai][m] = ssq_a[row]; qp[ai][m] = ssq_p[row]; }
#pragma unroll
        for (int ai = 0; ai < 2; ++ai)
#pragma unroll
            for (int m = 0; m < 4; ++m) { const float f = __builtin_amdgcn_sqrtf((qp[ai][m] * inv_w_mid + RMS_EPS) * __builtin_amdgcn_rcpf(qa[ai][m] * inv_w_mid + RMS_EPS));
#pragma unroll
                for (int bj = 0; bj < 2; ++bj)
#pragma unroll
                    for (int n = 0; n < 2; ++n) acc[ai][bj][m][n] *= f; }
    }
    template <class Src> __device__ __forceinline__ void run(const Src& src, const Unit& u, int wr, int wc, int fr, int fq) const {
        const int row0 = u.pm * BM + wr * 64 + fr, col0 = u.pn * BM + wc * 32 + 4 * fq;
        const float* base = (u.pm * BM < MP) ? base0 : base1;
        const float* pt = nullptr;
        float scv[2][4];
        if (ssq_rs) { row_scales(ssq_rs, inv_w_rs, row0, scv);
#pragma unroll
            for (int ai = 0; ai < 2; ++ai)
#pragma unroll
                for (int m = 0; m < 4; ++m) scv[ai][m] *= alpha; }
        else {
#pragma unroll
            for (int ai = 0; ai < 2; ++ai)
#pragma unroll
                for (int m = 0; m < 4; ++m) scv[ai][m] = alpha; }
        if constexpr (ADD_SLAB) {
            if (threadIdx.x == 0) { unsigned sp = 0;
                while (__hip_atomic_load(flag, __ATOMIC_RELAXED, __HIP_MEMORY_SCOPE_AGENT) == 0u) { __builtin_amdgcn_s_sleep(8); if (++sp > (1u << 22)) { atomicAdd(tmo, 1u); break; } }
                __builtin_amdgcn_fence(__ATOMIC_ACQUIRE, "agent"); asm volatile("s_waitcnt vmcnt(0)" ::: "memory"); }
            asm volatile("" ::: "memory"); __builtin_amdgcn_s_barrier(); asm volatile("" ::: "memory");
            pt = slab + (size_t)u.pn * 65536 + (size_t)(wr * 64 + fr) * 256 + wc * 32 + 4 * fq; }
#pragma unroll
        for (int ai = 0; ai < 2; ++ai) {
            u32x2 bw[4][2][2];
            if constexpr (BASE_BF16) {
#pragma unroll
                for (int m = 0; m < 4; ++m)
#pragma unroll
                    for (int bj = 0; bj < 2; ++bj)
#pragma unroll
                        for (int n = 0; n < 2; ++n) bw[m][bj][n] = *(const u32x2*)(baseb + (size_t)(row0 + ai * HALF + m * 16) * DM + col0 + bj * HALF + n * 16); }
#pragma unroll
            for (int m = 0; m < 4; ++m) { const int row = row0 + ai * HALF + m * 16; const size_t off = (size_t)row * DM + col0;
                const float sc = scv[ai][m]; float s = 0.f; float pre = 1.0f; if constexpr (PRE_SCALE) pre = midf(row);
                f32x4 sl[2][2];
                if constexpr (ADD_SLAB) {
#pragma unroll
                    for (int bj = 0; bj < 2; ++bj)
#pragma unroll
                        for (int n = 0; n < 2; ++n) sl[bj][n] = *(const f32x4*)(pt + (ai * HALF + m * 16) * 256 + bj * HALF + n * 16); }
#pragma unroll
                for (int bj = 0; bj < 2; ++bj)
#pragma unroll
                    for (int n = 0; n < 2; ++n) { const int co = bj * HALF + n * 16; f32x4 b;
                        if constexpr (BASE_BF16) { const u32x2 w = bw[m][bj][n]; b = (f32x4){bf_lo(w.x), bf_hi(w.x), bf_lo(w.y), bf_hi(w.y)}; }
                        else b = *(const f32x4*)(base + off + co);
                        f32x4 a4 = src(ai, bj, m, n); if constexpr (PRE_SCALE) a4 *= pre; if constexpr (ADD_SLAB) a4 += sl[bj][n];
                        const f32x4 v = b + a4 * sc;
                        *(u32x2*)(outb + off + co) = pk4(v); s += dot4(v); }
                s += __shfl_xor(s, 16); s += __shfl_xor(s, 32); if (fq == 0) atomicAdd(ssq_out + row, s);
                if (m & 1) asm volatile("" ::: "memory"); }
        }
    }
};
struct EpiIn {
    static constexpr bool AFTER_DRAIN = false, MID = false, FINAL = false;
    const float* ssq; float inv_w; bf16_t *qb, *kb, *vb, *xp; float* out;
    template <class Src> __device__ __forceinline__ void run(const Src& src, const Unit& u, int wr, int wc, int fr, int fq) const {
        const int row0 = u.pm * BM + wr * 64 + fr, seg = u.pn >> 2, cseg = (u.pn & 3) * BM + wc * 32 + 4 * fq;
        const bool prompt = u.pm * BM < MP;
        float rsv[2][4]; row_scales(ssq, inv_w, row0, rsv);
#pragma unroll
        for (int ai = 0; ai < 2; ++ai)
#pragma unroll
            for (int m = 0; m < 4; ++m) { const int row = row0 + ai * HALF + m * 16; const float r = rsv[ai][m]; const size_t off = (size_t)row * SBW + cseg;
                float* fo = nullptr; float* po = nullptr;
                if (seg == 1) fo = prompt ? out + OFF_KP + off : out + OFF_KS + ((size_t)(row - MP) * SBW + cseg);
                if (seg == 2) fo = prompt ? out + OFF_VP + off : out + OFF_VS + ((size_t)(row - MP) * SBW + cseg);
                if (seg == 3) { if (prompt) { const int b = row / SEQ, t = row % SEQ; if (t >= SEQ - PSTATE) po = out + OFF_PP + ((size_t)(b * PSTATE + t - (SEQ - PSTATE)) * PWID + cseg); }
                                else { const int rs_ = row - MP, b = rs_ / DECS, t = rs_ % DECS; if (t >= DECS - PSTATE) po = out + OFF_PS + ((size_t)(b * PSTATE + t - (DECS - PSTATE)) * PWID + cseg); } }
#pragma unroll
                for (int bj = 0; bj < 2; ++bj)
#pragma unroll
                    for (int n = 0; n < 2; ++n) { const int co = bj * HALF + n * 16; const f32x4 v = src(ai, bj, m, n) * r;
                        if (seg == 0) *(u32x2*)(qb + off + co) = pk4(v * QSCALE);
                        else if (seg == 1) { *(u32x2*)(kb + off + co) = pk4(v); __builtin_nontemporal_store(v, (f32x4*)(fo + co)); }
                        else if (seg == 2) { *(u32x2*)(vb + off + co) = pk4(v); __builtin_nontemporal_store(v, (f32x4*)(fo + co)); }
                        else { *(u32x2*)(xp + off + co) = pk4(v); if (po) *(f32x4*)(po + co) = v; } }
                if (m & 1) asm volatile("" ::: "memory"); }
    }
};
struct EpiPle {
    static constexpr bool AFTER_DRAIN = false, MID = false, FINAL = false;
    bf16_t* h; const bf16_t* hb; const bf16_t* proj; const float* ssq; float inv_w; float* ssq_out;
    template <class Src> __device__ __forceinline__ void run(const Src& src, const Unit& u, int wr, int wc, int fr, int fq) const {
        const int row0 = u.pm * BM + wr * 64 + fr, col0 = u.pn * BM + wc * 32 + 4 * fq;
        float rsv[2][4]; row_scales(ssq, inv_w, row0, rsv);
#pragma unroll
        for (int ai = 0; ai < 2; ++ai) {
            u32x2 hw[4][2][2], pj[4][2][2];
#pragma unroll
            for (int m = 0; m < 4; ++m)
#pragma unroll
                for (int bj = 0; bj < 2; ++bj)
#pragma unroll
                    for (int n = 0; n < 2; ++n) { const size_t o = (size_t)(row0 + ai * HALF + m * 16) * DM + col0 + bj * HALF + n * 16; hw[m][bj][n] = *(const u32x2*)(hb + o); pj[m][bj][n] = *(const u32x2*)(proj + o); }
#pragma unroll
            for (int m = 0; m < 4; ++m) { const int row = row0 + ai * HALF + m * 16; const size_t off = (size_t)row * DM + col0; const float r = rsv[ai][m]; float s = 0.f;
#pragma unroll
                for (int bj = 0; bj < 2; ++bj)
#pragma unroll
                    for (int n = 0; n < 2; ++n) { const int co = bj * HALF + n * 16; const u32x2 w = hw[m][bj][n], p = pj[m][bj][n]; const f32x4 b = (f32x4){bf_lo(w.x), bf_hi(w.x), bf_lo(w.y), bf_hi(w.y)};
                        const f32x4 g = src(ai, bj, m, n) * r; f32x4 v;
                        v[0] = b[0] + sigmoidf_(g[0]) * bf_lo(p.x); v[1] = b[1] + sigmoidf_(g[1]) * bf_hi(p.x); v[2] = b[2] + sigmoidf_(g[2]) * bf_lo(p.y); v[3] = b[3] + sigmoidf_(g[3]) * bf_hi(p.y);
                        *(u32x2*)(h + off + co) = pk4(v); s += dot4(v); }
                s += __shfl_xor(s, 16); s += __shfl_xor(s, 32); if (fq == 0) atomicAdd(ssq_out + row, s);
                if (m & 1) asm volatile("" ::: "memory"); }
        }
    }
};

template <class Epi, class Sched, bool ALIGN_EPI = true>
__device__ __forceinline__ void gemm_phase(PG8_LAS unsigned char* lds, const Gemm g, const Sched& S, const Epi& E) {
    const int tid = threadIdx.x, wid = __builtin_amdgcn_readfirstlane(tid >> 6), lane = tid & 63, wr = wid >> 2, wc = wid & 3, fr = lane & 15, fq = lane >> 4;
    int K_ = g.K; asm volatile("" : "+s"(K_));
    const int K = K_, nt = K / BK;
    unsigned voffA[2], voffB[2];
#pragma unroll
    for (int i = 0; i < 2; ++i) { int R, C; stage_rc(tid * 16 + i * 8192, R, C); voffA[i] = (unsigned)(R * g.lda + C) * 2u; voffB[i] = (unsigned)(R * g.ldb + C) * 2u; }
    const size_t kstep = (size_t)(BK * 2);
    const size_t hstepA = (size_t)HALF * g.lda * 2, hstepB = (size_t)HALF * g.ldb * 2;
    const size_t tstepA = 2 * hstepA, tstepB = 2 * hstepB;
    const unsigned ldsw = (unsigned)wid * 1024u;
    const int aoff = lds_byte(wr * 64 + fr, fq * 8), boff = lds_byte(wc * 32 + fr, fq * 8);
#define PG8_SA(b, h) (((b) * 2 + (h)) * HTB)
#define PG8_SB(b, h) ((4 + (b) * 2 + (h)) * HTB)
#define PG8_STAGE(bufoff, gbase, voff) do { _Pragma("unroll") for (int _i = 0; _i < 2; ++_i) \
        __builtin_amdgcn_global_load_lds((const unsigned*)((const char*)(gbase) + (voff)[_i]), (PG8_LAS unsigned*)(lds + (bufoff) + ldsw + _i * 8192), 16, 0, 0); } while (0)
#define PG8_LDA(dst, b, h) do { _Pragma("unroll") for (int m = 0; m < 4; ++m) _Pragma("unroll") for (int k = 0; k < 2; ++k) dst[m][k] = *(const PG8_LAS bf16x8*)(lds + PG8_SA(b, h) + aoff + m * 2048 + k * 1024); } while (0)
#define PG8_LDB(dst, b, h) do { _Pragma("unroll") for (int n = 0; n < 2; ++n) _Pragma("unroll") for (int k = 0; k < 2; ++k) dst[n][k] = *(const PG8_LAS bf16x8*)(lds + PG8_SB(b, h) + boff + n * 2048 + k * 1024); } while (0)
#define PG8_MMA(ai, bj, At, Bt) do { __builtin_amdgcn_s_setprio(1); _Pragma("unroll") for (int m = 0; m < 4; ++m) _Pragma("unroll") for (int n = 0; n < 2; ++n) _Pragma("unroll") for (int k = 0; k < 2; ++k) \
        acc[ai][bj][m][n] = __builtin_amdgcn_mfma_f32_16x16x32_bf16(Bt[n][k], At[m][k], acc[ai][bj][m][n], 0, 0, 0); __builtin_amdgcn_s_setprio(0); } while (0)
#define PG8_WAIT_V(n) asm volatile("s_waitcnt vmcnt(" #n ")" ::: "memory")
#define PG8_WAIT_L(n) asm volatile("s_waitcnt lgkmcnt(" #n ")" ::: "memory")
#define PG8_BAR __builtin_amdgcn_s_barrier()
#define PG8_SCHED __builtin_amdgcn_sched_barrier(0)
    Unit cur, nxt; int ui = 0;
    if (!S.next(0, cur)) return;
    f32x4 acc[2][2][4][2];
#pragma unroll
    for (int a = 0; a < 2; ++a)
#pragma unroll
        for (int b = 0; b < 2; ++b)
#pragma unroll
            for (int m = 0; m < 4; ++m)
#pragma unroll
                for (int n = 0; n < 2; ++n) acc[a][b][m][n] = (f32x4){0.f, 0.f, 0.f, 0.f};
    bf16x8 At[4][2], B0[2][2], B1[2][2];
    const char* cA = (const char*)g.A + (size_t)cur.pm * tstepA + (size_t)cur.pn * g.a_pn_off * 2 + (size_t)cur.kt0 * kstep; const char* cB = (const char*)g.Bt + (size_t)cur.pn * tstepB + (size_t)cur.kt0 * kstep;
    S.a_ready(cur);
    PG8_STAGE(PG8_SB(0, 0), cB, voffB); PG8_STAGE(PG8_SB(0, 1), cB + hstepB, voffB); PG8_STAGE(PG8_SA(0, 0), cA, voffA); PG8_STAGE(PG8_SA(0, 1), cA + hstepA, voffA);
    if (wr == 1) PG8_BAR;
    PG8_WAIT_V(2); PG8_BAR;
    PG8_STAGE(PG8_SB(1, 0), cB + kstep, voffB); PG8_STAGE(PG8_SA(1, 0), cA + kstep, voffA); PG8_STAGE(PG8_SB(1, 1), cB + hstepB + kstep, voffB);
    PG8_WAIT_V(6); PG8_BAR;
    for (;;) {
        const bool has_next = S.next(ui + 1, nxt);
        const char* nA = has_next ? (const char*)g.A + (size_t)nxt.pm * tstepA + (size_t)nxt.pn * g.a_pn_off * 2 + (size_t)nxt.kt0 * kstep : cA; const char* nB = has_next ? (const char*)g.Bt + (size_t)nxt.pn * tstepB + (size_t)nxt.kt0 * kstep : cB;
        const int unt = cur.nkt;
        for (int t = 0; t < unt; t += 2) {
            const bool last = (t == unt - 2);
            const char* a1 = cA + (size_t)(t + 1) * kstep;
            const char* a2 = last ? nA : cA + (size_t)(t + 2) * kstep; const char* b2 = last ? nB : cB + (size_t)(t + 2) * kstep;
            const char* a3 = a2 + kstep; const char* b3 = b2 + kstep;
            if (last && has_next) S.a_ready(nxt);
            PG8_LDB(B0, 0, 0); PG8_LDB(B1, 0, 1); PG8_SCHED; PG8_LDA(At, 0, 0); PG8_STAGE(PG8_SA(1, 1), a1 + hstepA, voffA);
            PG8_WAIT_V(8); PG8_WAIT_L(0); PG8_BAR; PG8_MMA(0, 0, At, B0); PG8_MMA(0, 1, At, B1); PG8_BAR; PG8_SCHED;
            PG8_LDA(At, 0, 1); PG8_STAGE(PG8_SB(0, 0), b2, voffB); PG8_STAGE(PG8_SB(0, 1), b2 + hstepB, voffB); PG8_STAGE(PG8_SA(0, 0), a2, voffA);
            PG8_WAIT_V(8); PG8_WAIT_L(0); PG8_BAR; PG8_MMA(1, 0, At, B0); PG8_MMA(1, 1, At, B1); PG8_BAR; PG8_SCHED;
            PG8_LDB(B0, 1, 0); PG8_LDB(B1, 1, 1); PG8_SCHED; PG8_LDA(At, 1, 0); PG8_STAGE(PG8_SA(0, 1), a2 + hstepA, voffA);
            PG8_WAIT_V(8); PG8_WAIT_L(0); PG8_BAR; PG8_MMA(0, 0, At, B0); PG8_MMA(0, 1, At, B1); PG8_BAR; PG8_SCHED;
            PG8_LDA(At, 1, 1); PG8_STAGE(PG8_SB(1, 0), b3, voffB); PG8_STAGE(PG8_SB(1, 1), b3 + hstepB, voffB); PG8_STAGE(PG8_SA(1, 0), a3, voffA);
            PG8_WAIT_V(8); PG8_WAIT_L(0); PG8_BAR; PG8_MMA(1, 0, At, B0); PG8_MMA(1, 1, At, B1); PG8_BAR; PG8_SCHED;
        }
        if constexpr (ALIGN_EPI) { if (wr == 0) PG8_BAR; }
        bool carry = false;
        if constexpr (Epi::MID) carry = cur.part == 2;
        Unit eu = cur; asm volatile("" : "+s"(eu.pm), "+s"(eu.pn));
        if (carry) { if constexpr (Epi::MID) E.mid(acc, eu, wr, wc, fr, fq); }
        else if constexpr (Epi::FINAL) E.run_final(acc, eu, wr, wc, fr, fq);
        else E.run(AccSrc{acc}, eu, wr, wc, fr, fq);
        S.done(cur);
        if (!has_next) break;
        if (!carry) {
#pragma unroll
        for (int a = 0; a < 2; ++a)
#pragma unroll
            for (int b = 0; b < 2; ++b)
#pragma unroll
                for (int m = 0; m < 4; ++m)
#pragma unroll
                    for (int n = 0; n < 2; ++n) acc[a][b][m][n] = (f32x4){0.f, 0.f, 0.f, 0.f};
        }
        cur = nxt; cA = nA; cB = nB; ++ui;
        if constexpr (ALIGN_EPI) { if (wr == 1) PG8_BAR; }
    }
    PG8_WAIT_V(0);
    if constexpr (!ALIGN_EPI) { if (wr == 0) PG8_BAR; }
    PG8_BAR;
#undef PG8_SA
#undef PG8_SB
#undef PG8_STAGE
#undef PG8_LDA
#undef PG8_LDB
#undef PG8_MMA
#undef PG8_WAIT_V
#undef PG8_WAIT_L
#undef PG8_BAR
#undef PG8_SCHED
}
}

constexpr int NWAVES = 8;
constexpr int PER_PHASE = 11;
constexpr int N_LAUNCHES = MK_N_LAUNCHES;

#define GAS __attribute__((address_space(1)))
#define LAS __attribute__((address_space(3)))
typedef unsigned short bf16;
typedef unsigned v4u __attribute__((ext_vector_type(4)));
typedef unsigned v2u __attribute__((ext_vector_type(2)));
typedef float f32x4 __attribute__((ext_vector_type(4)));
typedef float f32x16 __attribute__((ext_vector_type(16)));
typedef short bf16x8 __attribute__((ext_vector_type(8)));
typedef short s16x4 __attribute__((ext_vector_type(4)));
typedef GAS unsigned gu32;
#define RLX_AGENT __ATOMIC_RELAXED, __HIP_MEMORY_SCOPE_AGENT
#define LDS_WAIT() asm volatile("s_waitcnt lgkmcnt(0)" ::: "memory")
#define VM_WAIT() asm volatile("s_waitcnt vmcnt(0)" ::: "memory")
using pg8::pk2; using pg8::pk4;

constexpr size_t MiB = 1u << 20;
constexpr size_t al(size_t x) { return (x + MiB - 1) / MiB * MiB; }
constexpr size_t WS_CTL = 0, CTL_ZERO_BYTES = 1 * MiB;
constexpr size_t WS_W1C = 1 * MiB;
constexpr size_t WS_W1D = WS_W1C + al((size_t)NCAT * DM * 2);
constexpr size_t WS_WIN = WS_W1D + al((size_t)DM * FF * 2);
constexpr size_t WS_WOUT = WS_WIN + al((size_t)NIN * DM * 2);
constexpr size_t WS_W2C = WS_WOUT + al((size_t)DM * DM * 2);
constexpr size_t WS_W2D = WS_W2C + al((size_t)NCAT * DM * 2);
constexpr size_t WS_WPG = WS_W2D + al((size_t)DM * FF * 2);
constexpr size_t WS_WPP = WS_WPG + al((size_t)DM * DM * 2);
constexpr size_t WS_WPOOL = WS_WPP + al((size_t)DM * PLE * 2);
constexpr size_t WS_HB = WS_WPOOL + al((size_t)PWID * 256 * 2);
constexpr size_t WS_G = WS_HB + al((size_t)M * DM * 2);
constexpr size_t WS_QB = WS_G + al((size_t)M * FF * 2);
constexpr size_t WS_KB = WS_QB + al((size_t)M * SBW * 2);
constexpr size_t WS_VB = WS_KB + al((size_t)M * SBW * 2);
constexpr size_t WS_XP = WS_VB + al((size_t)M * SBW * 2);
constexpr size_t WS_PLB = WS_XP + al((size_t)M * PWID * 2);
constexpr size_t WS_C = WS_PLB + al((size_t)M * PWID * 2);
constexpr size_t WS_PROJ = WS_C + al((size_t)M * DM * 2);
constexpr size_t WS_PB = WS_PROJ + al((size_t)M * DM * 2);
constexpr size_t WS_SLAB = WS_PB + al((size_t)M * PLE * 2);
constexpr size_t WS_END = WS_SLAB + 4 * MiB;
constexpr int CW_BAR = 4096;
constexpr int CW_RANK = 12288;
constexpr int CW_CNT = 8192;
constexpr int CW_SSQ = 16384;
constexpr int SSQ_STRIDE = 8704;
static_assert((CW_SSQ + 7 * SSQ_STRIDE) * 4 <= (int)CTL_ZERO_BYTES && SSQ_STRIDE >= M, "CTL words inside the memset region");

constexpr int RING_OFF = 0, RING_BYTES = 131072;
constexpr int LDSCTL_OFF = RING_BYTES, MISC_OFF = LDSCTL_OFF + 320;
constexpr int LDS_BYTES = 147456;

__device__ __forceinline__ float wave_sum(float v) {
#pragma unroll
    for (int o = 1; o < 64; o <<= 1) v += __shfl_xor(v, o);
    return v;
}

#define XB_TMO      128
#define XB_XCNT(j)  (256  + 64 * (j))
#define XB_XSUB(j)  (1280 + 64 * (j))
#define XB_XGEN(j)  (2304 + 64 * (j))
#define XB_TOP      3328
#define XB_TOPGEN   3392
#define XCD_BAR_WORDS 3456
#define XB_SPIN_CAP (1u << 18)
__device__ __forceinline__ unsigned xb_ld(unsigned* p)              { return __hip_atomic_load(p, __ATOMIC_RELAXED, __HIP_MEMORY_SCOPE_AGENT); }
__device__ __forceinline__ unsigned xb_add(unsigned* p, unsigned v) { return __hip_atomic_fetch_add(p, v, __ATOMIC_RELAXED, __HIP_MEMORY_SCOPE_AGENT); }
__device__ __forceinline__ unsigned xb_xcc_id() { return (unsigned)__builtin_amdgcn_s_getreg((3 << 11) | 20) & 0xFu; }
#define XB_SPIN(cond, bar) do { unsigned _sp = 0; while (cond) { __builtin_amdgcn_s_sleep(1); \
    if ((++_sp & 255u) == 0u) { if (xb_ld(&(bar)[XB_TMO])) break; if (_sp > XB_SPIN_CAP) { atomicAdd(&(bar)[XB_TMO], 1u); break; } } } } while (0)
struct XcdBarrier { unsigned* bar; unsigned x; volatile LAS unsigned* st; };
__device__ __forceinline__ XcdBarrier xcd_barrier_post(unsigned* bar, volatile LAS unsigned* st) {
    XcdBarrier b; b.bar = bar; b.x = xb_xcc_id(); b.st = st;
    if (threadIdx.x == 0) (void)xb_add(&bar[XB_XCNT(b.x)], 1u);
    return b;
}
__device__ __forceinline__ void xcd_barrier_complete(unsigned* bar, unsigned x, unsigned& nloc, unsigned& nx) {
    const unsigned G = gridDim.x * gridDim.y * gridDim.z;
    unsigned sum, cnt, mine, sp = 0u;
    for (;;) {
        sum = 0u; cnt = 0u; mine = 0u;
#pragma unroll
        for (unsigned j = 0; j < 16; ++j) { const unsigned c = xb_ld(&bar[XB_XCNT(j)]); sum += c; cnt += (c > 0u) ? 1u : 0u; mine = (j == x) ? c : mine; }
        if (sum == G) break;
        __builtin_amdgcn_s_sleep(1);
        if ((++sp & 255u) == 0u) { if (xb_ld(&bar[XB_TMO])) break; if (sp > XB_SPIN_CAP) { atomicAdd(&bar[XB_TMO], 1u); break; } }
    }
    nloc = mine > 0u ? mine : 1u; nx = cnt > 0u ? cnt : 1u;
}
__device__ __forceinline__ void xcd_barrier(const XcdBarrier& b) {
    asm volatile("s_waitcnt vmcnt(0)" ::: "memory");
    __syncthreads();
    if (threadIdx.x == 0) {
        unsigned* bar = b.bar;
        __builtin_amdgcn_s_waitcnt(0);
        unsigned nloc = b.st[0], nx = b.st[1];
        if (nloc == 0u) { xcd_barrier_complete(bar, b.x, nloc, nx); b.st[0] = nloc; b.st[1] = nx; }
        const unsigned old = xb_add(&bar[XB_XSUB(b.x)], 1u);
        const unsigned gen = old / nloc;
        if (old + 1u == (gen + 1u) * nloc) {
            __builtin_amdgcn_fence(__ATOMIC_RELEASE, "agent");
            asm volatile("s_waitcnt vmcnt(0)" ::: "memory");
            const unsigned og = xb_add(&bar[XB_TOP], 1u);
            const unsigned tg = og / nx;
            if (og + 1u == (tg + 1u) * nx) xb_add(&bar[XB_TOPGEN], 1u);
            else XB_SPIN(xb_ld(&bar[XB_TOPGEN]) == tg, bar);
            __builtin_amdgcn_fence(__ATOMIC_ACQUIRE, "agent");
            xb_add(&bar[XB_XGEN(b.x)], 1u);
            asm volatile("s_waitcnt vmcnt(0)" ::: "memory");
        } else {
            XB_SPIN(xb_ld(&bar[XB_XGEN(b.x)]) == gen, bar);
            __builtin_amdgcn_fence(__ATOMIC_ACQUIRE, "agent");
            asm volatile("s_waitcnt vmcnt(0)" ::: "memory");
        }
    }
    __syncthreads();
}

struct Frame {
    LAS unsigned char* lds;
    volatile LAS unsigned* MISC;
    unsigned* ctl; unsigned char* ws;
    int tid, lane, wave, vcu, G;
    const float* in[25];
    float* out;
    bf16 *W1C, *W1D, *WIN, *WOUT, *W2C, *W2D, *WPG, *WPP, *WPOOL;
    bf16 *HB, *GB, *QB, *KB, *VB, *PLB, *CB, *PROJ, *PB;
    bf16* XP;
    float *ssq0, *ssq1, *ssqA, *ssqP, *ssq2, *ssq3, *ssq4;
};
enum { I_XP = 0, I_XS, I_CK, I_CV, I_SPOOL, I_PP, I_PS, I_GFFN1, I_W1G, I_W1U, I_W1D, I_GMIX, I_WIN, I_GATT, I_WPOOL, I_PSCALE, I_WOUT, I_GFFN2, I_W2G, I_W2U, I_W2D, I_GPLE, I_WPG, I_WPP, I_GFINAL };

constexpr int TRP = 66;
__device__ __forceinline__ void tr_item(const float* W, int N, const float* ga, bf16* WT, int Kdst, int k0, int n0, int drow0, LAS unsigned short* scr, int lane) {
    const int r4 = lane >> 4, c4 = lane & 15;
    f32x4 v[16];
#pragma unroll
    for (int i = 0; i < 16; ++i) v[i] = __builtin_nontemporal_load((const GAS f32x4*)(W + (size_t)(k0 + 4 * i + r4) * N + n0 + 4 * c4));
#pragma unroll
    for (int i = 0; i < 16; ++i) { f32x4 x = v[i]; if (ga) x = x * ga[k0 + 4 * i + r4];
        const v2u w = pk4(x); LAS unsigned* d = (LAS unsigned*)(scr + (4 * i + r4) * TRP + 4 * c4); d[0] = w.x; d[1] = w.y; }
    LDS_WAIT(); asm volatile("" ::: "memory");
    const int c = lane & 7;
#pragma unroll
    for (int j = 0; j < 8; ++j) { const int n = (lane >> 3) + 8 * j; const LAS unsigned short* p = scr + (8 * c) * TRP + n;
        v4u o; o.x = (unsigned)p[0] | ((unsigned)p[TRP] << 16); o.y = (unsigned)p[2 * TRP] | ((unsigned)p[3 * TRP] << 16); o.z = (unsigned)p[4 * TRP] | ((unsigned)p[5 * TRP] << 16); o.w = (unsigned)p[6 * TRP] | ((unsigned)p[7 * TRP] << 16);
        *(GAS v4u*)(WT + (size_t)(drow0 + n) * Kdst + k0 + 8 * c) = o; }
    LDS_WAIT(); asm volatile("" ::: "memory");
}
__device__ __forceinline__ void tr_plain(const float* W, int K, int N, const float* ga, const float* gb, int ghalf, bf16* WT, int r, LAS unsigned short* scr, int lane) {
    const int nblk = N / 64, kb = r / nblk, nb = r % nblk; const float* gk = (64 * kb < ghalf) ? ga : gb;
    tr_item(W, N, gk, WT, K, 64 * kb, 64 * nb, 64 * nb, scr, lane);
}
__device__ __forceinline__ void tr_cat(const float* W, const float* ga, bf16* WT, int half, int r, LAS unsigned short* scr, int lane) {
    const int nblk = FF / 64, kb = r / nblk, nb = r % nblk, n0 = 64 * nb; tr_item(W, FF, ga, WT, DM, 64 * kb, n0, (n0 >> 7) * 256 + half * 128 + (n0 & 127), scr, lane);
}
__device__ __forceinline__ void p0_prologue(Frame& F) {
    LAS unsigned short* scr = (LAS unsigned short*)(F.lds + RING_OFF + F.wave * 16384);
    const int gw = F.vcu * NWAVES + F.wave, NGW = F.G * NWAVES;
    constexpr int I_CAT = (DM / 64) * (FF / 64), I_DN = (FF / 64) * (DM / 64), I_IN = (DM / 64) * (NIN / 64), I_SQ = (DM / 64) * (DM / 64), I_PPJ = (PLE / 64) * (DM / 64), I_PL = 4 * (256 / 64) * (256 / 64);
    constexpr int NITEMS = 4 * I_CAT + 2 * I_DN + I_IN + 2 * I_SQ + I_PPJ + I_PL;
    constexpr int NLATE = NITEMS - 2 * I_CAT;
    for (int it = gw; it < NLATE; it += NGW) {
        int r = it;
        if (r < I_SQ) { tr_plain(F.in[I_WPG], DM, DM, F.in[I_GPLE], nullptr, 1 << 30, F.WPG, r, scr, F.lane); continue; } r -= I_SQ;
        if (r < I_DN) { tr_plain(F.in[I_W2D], FF, DM, nullptr, nullptr, 0, F.W2D, r, scr, F.lane); continue; } r -= I_DN;
        if (r < I_CAT) { tr_cat(F.in[I_W2U], F.in[I_GFFN2], F.W2C, 1, r, scr, F.lane); continue; } r -= I_CAT;
        if (r < I_CAT) { tr_cat(F.in[I_W2G], F.in[I_GFFN2], F.W2C, 0, r, scr, F.lane); continue; } r -= I_CAT;
        if (r < I_SQ) { tr_plain(F.in[I_WOUT], DM, DM, F.in[I_GATT], F.in[I_PSCALE] - SBW, SBW, F.WOUT, r, scr, F.lane); continue; } r -= I_SQ;
        if (r < I_PL) { const int g = r / 16, rr = r % 16; tr_plain(F.in[I_WPOOL] + (size_t)g * 65536, 256, 256, nullptr, nullptr, 0, F.WPOOL + (size_t)g * 65536, rr, scr, F.lane); continue; } r -= I_PL;
        if (r < I_IN) { tr_plain(F.in[I_WIN], DM, NIN, F.in[I_GMIX], nullptr, 1 << 30, F.WIN, r, scr, F.lane); continue; } r -= I_IN;
        if (r < I_DN) { tr_plain(F.in[I_W1D], FF, DM, nullptr, nullptr, 0, F.W1D, r, scr, F.lane); continue; } r -= I_DN;
        tr_plain(F.in[I_WPP], PLE, DM, nullptr, nullptr, 0, F.WPP, r, scr, F.lane);
    }
    for (int m0 = gw; m0 < M; m0 += 2 * NGW) {
        const int m1 = m0 + NGW; const bool two = m1 < M;
        const float* xr0 = (m0 < MP) ? F.in[I_XP] + (size_t)m0 * DM : F.in[I_XS] + (size_t)(m0 - MP) * DM;
        const float* pr0 = (m0 < MP) ? F.in[I_PP] + (size_t)m0 * PLE : F.in[I_PS] + (size_t)(m0 - MP) * PLE;
        const int mm1 = two ? m1 : m0;
        const float* xr1 = (mm1 < MP) ? F.in[I_XP] + (size_t)mm1 * DM : F.in[I_XS] + (size_t)(mm1 - MP) * DM;
        const float* pr1 = (mm1 < MP) ? F.in[I_PP] + (size_t)mm1 * PLE : F.in[I_PS] + (size_t)(mm1 - MP) * PLE;
        f32x4 v0[8], v1[8]; float s0 = 0.f, s1 = 0.f;
#pragma unroll
        for (int j = 0; j < 8; ++j) { v0[j] = __builtin_nontemporal_load((const GAS f32x4*)xr0 + F.lane + 64 * j); v1[j] = __builtin_nontemporal_load((const GAS f32x4*)xr1 + F.lane + 64 * j); }
        const f32x4 p0 = ((const GAS f32x4*)pr0)[F.lane], p1 = ((const GAS f32x4*)pr1)[F.lane];
#pragma unroll
        for (int j = 0; j < 8; ++j) { s0 += pg8::dot4(v0[j]); s1 += pg8::dot4(v1[j]); }
        s0 = wave_sum(s0); s1 = wave_sum(s1);
        if (F.lane == 0) { F.ssq0[m0] = s0; if (two) F.ssq0[m1] = s1; }
        GAS v2u* o0 = (GAS v2u*)(F.HB + (size_t)m0 * DM) + F.lane; GAS v2u* o1 = (GAS v2u*)(F.HB + (size_t)mm1 * DM) + F.lane;
#pragma unroll
        for (int j = 0; j < 8; ++j) o0[64 * j] = pk4(v0[j]);
        ((GAS v2u*)(F.PB + (size_t)m0 * PLE))[F.lane] = pk4(p0);
        if (two) {
#pragma unroll
            for (int j = 0; j < 8; ++j) o1[64 * j] = pk4(v1[j]);
            ((GAS v2u*)(F.PB + (size_t)m1 * PLE))[F.lane] = pk4(p1); }
    }
    for (int it = gw; it < 2 * I_CAT; it += NGW) { if (it < I_CAT) tr_cat(F.in[I_W1G], F.in[I_GFFN1], F.W1C, 0, it, scr, F.lane); else tr_cat(F.in[I_W1U], F.in[I_GFFN1], F.W1C, 1, it - I_CAT, scr, F.lane); }
}

__device__ __forceinline__ int crow(int r, int hi) { return (r & 3) + 8 * (r >> 2) + 4 * hi; }
__device__ __forceinline__ bf16x8 cvt8(f32x4 a, f32x4 b) { v4u w; w.x = pk2(a[0], a[1]); w.y = pk2(a[2], a[3]); w.z = pk2(b[0], b[1]); w.w = pk2(b[2], b[3]); return __builtin_bit_cast(bf16x8, w); }
typedef short v4i16_t __attribute__((ext_vector_type(4)));
__device__ __forceinline__ s16x4 vtr(LAS const unsigned char* p) { return __builtin_bit_cast(s16x4, __builtin_amdgcn_ds_read_tr16_b64_v4i16((LAS v4i16_t*)p)); }
constexpr int VPITCH = 272;
constexpr int VIMG_BYTES = 32 * VPITCH;
constexpr float SB_STOP = -135.0f;
constexpr int TA_S = 5;

template <bool SAMPLE>
__device__ __forceinline__ void sb_unit(const Frame& F, int b, int h, int qblk, LAS unsigned char* vl, bool dry = false) {
    const int lane = F.lane, qi = lane & 31, hi = lane >> 5;
    const int qrow = SAMPLE ? MP + b * DECS + qi : b * SEQ + qblk * 32 + qi;
    const bf16* qp = F.QB + (size_t)qrow * SBW + h * HD + hi * 8;
    bf16x8 qreg[8];
    if (!SAMPLE) {
#pragma unroll
        for (int ds = 0; ds < 8; ++ds) qreg[ds] = *(const bf16x8*)(qp + ds * 16); }
    f32x16 o[4];
#pragma unroll
    for (int db = 0; db < 4; ++db)
#pragma unroll
        for (int r = 0; r < 16; ++r) o[db][r] = 0.f;
    float R = 0.f;
    const int nblk = SAMPLE ? (PAST / 32 + 1) : qblk + 1;
    const int tr_base = ((4 * (lane >> 5) + ((lane & 15) >> 2)) * VPITCH) + (16 * ((lane >> 4) & 1) + 4 * (lane & 3)) * 2;
    const int srow0 = SAMPLE ? MP + b * DECS : b * SEQ;
    bf16x8 kf[8];
    if (!SAMPLE) { const bf16* kp = F.KB + (size_t)(srow0 + (nblk - 1) * 32 + qi) * SBW + h * HD + hi * 8;
#pragma unroll
      for (int ds = 0; ds < 8; ++ds) kf[ds] = *(const bf16x8*)(kp + ds * 16); }
    { unsigned tx = 0;
      if (SAMPLE) { unsigned tch[8 * TA_S + 4];
          { const size_t ro = (size_t)(srow0 + (lane & 31)) * SBW + h * HD + (lane >> 5) * 32;
            tch[8 * TA_S] = *(const GAS unsigned*)(F.KB + ro); tch[8 * TA_S + 1] = *(const GAS unsigned*)(F.KB + ro + 64); tch[8 * TA_S + 2] = *(const GAS unsigned*)(F.VB + ro); tch[8 * TA_S + 3] = *(const GAS unsigned*)(F.VB + ro + 64); }
#pragma unroll
          for (int i = 0; i < TA_S; ++i) { const size_t ro = (size_t)(b * PAST + (PAST / 32 - 1 - i) * 32 + (lane & 31)) * SBW + h * HD + (lane >> 5) * 16;
#pragma unroll
              for (int t = 0; t < 4; ++t) { tch[8 * i + t] = *(const GAS unsigned*)(F.in[I_CK] + ro + t * 32); tch[8 * i + 4 + t] = *(const GAS unsigned*)(F.in[I_CV] + ro + t * 32); } }
#pragma unroll
          for (int i = 0; i < 8 * TA_S + 4; ++i) tx ^= tch[i];
      }
      asm volatile("" :: "v"(tx)); }
    const unsigned vby_f32 = (unsigned)((lane >> 5) * SBW + (lane & 31) * 4) * 4u;
    const unsigned vby_b16 = (unsigned)((lane >> 4) * SBW + (lane & 15) * 8) * 2u;
    LAS unsigned char* const vl_f32 = vl + (lane >> 5) * VPITCH + (lane & 31) * 8;
    LAS unsigned char* const vl_b16 = vl + (lane >> 4) * VPITCH + (lane & 15) * 16;
    v4u vr[8];
    if (!SAMPLE) {
        const bf16* vp = F.VB + (size_t)(srow0 + (nblk - 1) * 32) * SBW + h * HD;
#pragma unroll
        for (int i = 0; i < 8; ++i) { const char* pb = (const char*)vp + (size_t)i * 4 * SBW * 2; asm volatile("" : "+s"(pb)); vr[i] = *(const GAS v4u*)(pb + vby_b16); } }
    for (int j = nblk - 1; j >= 0; --j) {
        const bool diag = (j == nblk - 1);
        const bool from_cache = SAMPLE && !diag;
        f32x16 st;
#pragma unroll
        for (int r = 0; r < 16; ++r) st[r] = 0.f;
        if (!from_cache) {
            if (SAMPLE) { const bf16* vp = F.VB + (size_t)srow0 * SBW + h * HD;
#pragma unroll
            for (int i = 0; i < 8; ++i) { const char* pb = (const char*)vp + (size_t)i * 4 * SBW * 2; asm volatile("" : "+s"(pb)); vr[i] = *(const GAS v4u*)(pb + vby_b16); } }
            if (SAMPLE) { const bf16* kp = F.KB + (size_t)(srow0 + qi) * SBW + h * HD + hi * 8;
#pragma unroll
                for (int ds = 0; ds < 8; ++ds) kf[ds] = *(const bf16x8*)(kp + ds * 16); }
#pragma unroll
            for (int ds = 0; ds < 8; ++ds) { bf16x8 qf; if (SAMPLE) qf = *(const bf16x8*)(qp + ds * 16); else qf = qreg[ds]; st = __builtin_amdgcn_mfma_f32_32x32x16_bf16(kf[ds], qf, st, 0, 0, 0); }
            if (!SAMPLE && j > 0) {
                const bf16* kp = F.KB + (size_t)(srow0 + (j - 1) * 32 + qi) * SBW + h * HD + hi * 8;
#pragma unroll
                for (int ds = 0; ds < 8; ++ds) kf[ds] = *(const bf16x8*)(kp + ds * 16); }
        } else {
            const float* kp = F.in[I_CK] + ((size_t)(b * PAST + j * 32 + qi) * SBW + h * HD + hi * 8);
            const float* vp = F.in[I_CV] + ((size_t)(b * PAST + j * 32) * SBW + h * HD);
#pragma unroll
            for (int hf = 0; hf < 2; ++hf) { f32x4 ka[4], kb[4];
#pragma unroll
              for (int d4 = 0; d4 < 4; ++d4) { ka[d4] = *(const f32x4*)(kp + (hf * 4 + d4) * 16); kb[d4] = *(const f32x4*)(kp + (hf * 4 + d4) * 16 + 4); }
#pragma unroll
              for (int d4 = 0; d4 < 4; ++d4) { const bf16x8 qf = *(const bf16x8*)(qp + (hf * 4 + d4) * 16); st = __builtin_amdgcn_mfma_f32_32x32x16_bf16(cvt8(ka[d4], kb[d4]), qf, st, 0, 0, 0); }
              asm volatile("" ::: "memory"); }
            { f32x4 vf[16];
#pragma unroll
              for (int i = 0; i < 16; ++i) { const char* pb = (const char*)vp + (size_t)i * 2 * SBW * 4; asm volatile("" : "+s"(pb)); vf[i] = *(const GAS f32x4*)(pb + vby_f32); }
#pragma unroll
              for (int i = 0; i < 16; ++i) *(LAS v2u*)(vl_f32 + i * 2 * VPITCH) = pk4(vf[i]); }
            asm volatile("" ::: "memory");
        }
        float bt[16], om[16];
#pragma unroll
        for (int r = 0; r < 16; ++r) { const float z = fmaxf(st[r], -125.0f);
            const float t = __builtin_amdgcn_exp2f(-z); float b_ = __builtin_amdgcn_rcpf(1.0f + t); float o_ = t * b_;
            if (diag && !(crow(r, hi) < qi)) { b_ = 0.f; o_ = 1.f; }
            bt[r] = b_; om[r] = o_; }
        float e[16], gs[4], pg[4];
#pragma unroll
        for (int g = 0; g < 4; ++g) { e[4 * g + 3] = 1.f; e[4 * g + 2] = om[4 * g + 3]; e[4 * g + 1] = e[4 * g + 2] * om[4 * g + 2]; e[4 * g] = e[4 * g + 1] * om[4 * g + 1]; gs[g] = e[4 * g] * om[4 * g]; }
#pragma unroll
        for (int g = 0; g < 4; ++g) pg[g] = __shfl_xor(gs[g], 32);
        const float scale = __builtin_amdgcn_exp2f(R);
        float after = 1.f; float a[16];
#pragma unroll
        for (int g = 3; g >= 0; --g) { const float tail = scale * after * (hi == 0 ? pg[g] : 1.f);
#pragma unroll
            for (int i = 0; i < 4; ++i) { const int r = 4 * g + i; a[r] = bt[r] * e[r] * tail; }
            after *= gs[g] * pg[g]; }
        R += __builtin_amdgcn_logf(after);
        bf16x8 xf[2];
#pragma unroll
        for (int s = 0; s < 2; ++s) { v4u w; w.x = pk2(a[8 * s + 0], a[8 * s + 1]); w.y = pk2(a[8 * s + 2], a[8 * s + 3]); w.z = pk2(a[8 * s + 4], a[8 * s + 5]); w.w = pk2(a[8 * s + 6], a[8 * s + 7]); xf[s] = __builtin_bit_cast(bf16x8, w); }
        asm volatile("" ::: "memory");
        if (!from_cache) {
#pragma unroll
            for (int i = 0; i < 8; ++i) *(LAS v4u*)(vl_b16 + i * 4 * VPITCH) = vr[i];
            if (!SAMPLE && j > 0) {
                const bf16* vp = F.VB + (size_t)(srow0 + (j - 1) * 32) * SBW + h * HD;
#pragma unroll
                for (int i = 0; i < 8; ++i) { const char* pb = (const char*)vp + (size_t)i * 4 * SBW * 2; asm volatile("" : "+s"(pb)); vr[i] = *(const GAS v4u*)(pb + vby_b16); } }
        }
        LDS_WAIT();
#pragma unroll
        for (int db = 0; db < 4; ++db)
#pragma unroll
            for (int s = 0; s < 2; ++s) { const LAS unsigned char* p = vl + tr_base + (16 * s) * VPITCH + db * 64;
                const s16x4 lo = vtr(p), hi4 = vtr(p + 8 * VPITCH);
                const bf16x8 va = (bf16x8){lo[0], lo[1], lo[2], lo[3], hi4[0], hi4[1], hi4[2], hi4[3]};
                o[db] = __builtin_amdgcn_mfma_f32_32x32x16_bf16(va, xf[s], o[db], 0, 0, 0); }
        LDS_WAIT(); asm volatile("" ::: "memory");
        if (__all(R < SB_STOP)) break;
    }
    float s = 0.f;
#pragma unroll
    for (int db = 0; db < 4; ++db)
#pragma unroll
        for (int r = 0; r < 16; ++r) s += o[db][r] * o[db][r];
    s += __shfl_xor(s, 32);
    if (hi == 0 && !dry) atomicAdd(F.ssqA + qrow, s);
    bf16* cp = F.CB + (size_t)qrow * DM + h * HD + 4 * hi;
#pragma unroll
    for (int db = 0; db < 4; ++db)
#pragma unroll
        for (int g = 0; g < 4; ++g) { v2u w; w.x = pk2(o[db][4 * g], o[db][4 * g + 1]); w.y = pk2(o[db][4 * g + 2], o[db][4 * g + 3]); *(v2u*)(cp + 32 * db + 8 * g) = w; }
}

__device__ __forceinline__ f32x4 ld_bf4(const bf16* p) { const v2u w = *(const v2u*)p; return (f32x4){pg8::bf_lo(w.x), pg8::bf_hi(w.x), pg8::bf_lo(w.y), pg8::bf_hi(w.y)}; }
template <int W>
__device__ __forceinline__ void pool_chunk(const bf16* xsrc, const float* past, int t0, int L, int pos0, bf16* dst, int g, int lane) {
    const int c = g * 256 + lane * 4;
    f32x4 hist[16];
#pragma unroll
    for (int j = 0; j < 16; ++j) { const int t = t0 - 16 + j; f32x4 v = (f32x4){0.f, 0.f, 0.f, 0.f};
        if (t >= 0) v = ld_bf4(xsrc + (size_t)t * PWID + c); else if (past && t >= -PSTATE) v = *(const f32x4*)(past + (size_t)(PSTATE + t) * PWID + c);
        hist[j] = v; }
    f32x4 S = (f32x4){0.f, 0.f, 0.f, 0.f};
#pragma unroll
    for (int i = 1; i <= W; ++i) S += hist[16 - i];
    for (int tb = t0; tb < t0 + L; tb += 16) {
        v2u xraw[16];
#pragma unroll
        for (int j = 0; j < 16; ++j) xraw[j] = *(const v2u*)(xsrc + (size_t)(tb + j) * PWID + c);
#pragma unroll
        for (int j = 0; j < 16; ++j) { const int t = tb + j; const f32x4 xn = (f32x4){pg8::bf_lo(xraw[j].x), pg8::bf_hi(xraw[j].x), pg8::bf_lo(xraw[j].y), pg8::bf_hi(xraw[j].y)};
            S += xn - hist[(j - W) & 15]; hist[j] = xn;
            const int pc = pos0 + t + 1; const float cnt = (float)(pc < W ? pc : W);
            const float icnt = 1.0f / cnt; const f32x4 pooled = S * icnt - xn;
            *(v2u*)(dst + (size_t)t * PWID + c) = pk4(pooled); }
    }
}
__device__ __forceinline__ void pool_unit(const Frame& F, int id) {
    const bf16* xsrc; const float* past = nullptr; bf16* dst; int t0, L, pos0, g;
    if (id < 1024) { const int b = id >> 8; g = (id >> 6) & 3; const int ch = id & 63; xsrc = F.XP + (size_t)b * SEQ * PWID; dst = F.PLB + (size_t)b * SEQ * PWID; t0 = ch * 32; L = 32; pos0 = 0; }
    else { const int k = id - 1024, b = k >> 2; g = k & 3; xsrc = F.XP + (size_t)(MP + b * DECS) * PWID; dst = F.PLB + (size_t)(MP + b * DECS) * PWID; past = F.in[I_SPOOL] + (size_t)b * PSTATE * PWID; t0 = 0; L = DECS; pos0 = PAST; }
    if (g == 0) pool_chunk<2>(xsrc, past, t0, L, pos0, dst, g, F.lane);
    else if (g == 1) pool_chunk<4>(xsrc, past, t0, L, pos0, dst, g, F.lane);
    else if (g == 2) pool_chunk<8>(xsrc, past, t0, L, pos0, dst, g, F.lane);
    else pool_chunk<16>(xsrc, past, t0, L, pos0, dst, g, F.lane);
}

__device__ __forceinline__ void publish_count(unsigned* cnt) {
    VM_WAIT(); __syncthreads();
    if (threadIdx.x == 0) { __builtin_amdgcn_fence(__ATOMIC_RELEASE, "agent"); VM_WAIT(); (void)__hip_atomic_fetch_add(cnt, 1u, __ATOMIC_RELAXED, __HIP_MEMORY_SCOPE_AGENT); }
}
__device__ __forceinline__ void wait_count(unsigned* cnt, unsigned need, unsigned* tmo) {
    if (threadIdx.x == 0) { unsigned sp = 0;
        while (__hip_atomic_load(cnt, __ATOMIC_RELAXED, __HIP_MEMORY_SCOPE_AGENT) < need) { __builtin_amdgcn_s_sleep(8); if (++sp > (1u << 22)) { atomicAdd(tmo, 1u); break; } }
        __builtin_amdgcn_fence(__ATOMIC_ACQUIRE, "agent"); VM_WAIT(); }
    __syncthreads();
}

__device__ __forceinline__ void xcd_local_barrier(unsigned* cntx, unsigned nloc, unsigned* tmo) {
    VM_WAIT(); __syncthreads();
    if (threadIdx.x == 0) {
        const unsigned old = __hip_atomic_fetch_add(cntx, 1u, __ATOMIC_RELAXED, __HIP_MEMORY_SCOPE_AGENT); const unsigned want = (old / nloc + 1u) * nloc; unsigned sp = 0;
        while (__hip_atomic_load(cntx, __ATOMIC_RELAXED, __HIP_MEMORY_SCOPE_AGENT) < want) { __builtin_amdgcn_s_sleep(1); if (++sp > (1u << 21)) { atomicAdd(tmo, 1u); break; } }
        __builtin_amdgcn_fence(__ATOMIC_ACQUIRE, "agent"); VM_WAIT(); }
    __syncthreads();
}

struct EpiPleFinal {
    static constexpr bool AFTER_DRAIN = false, MID = false, FINAL = true;
    float* y; const pg8::bf16_t* hb; const pg8::bf16_t* proj; const float* ssq; float inv_w; float* ssq4; const float* gfin;
    int mode; unsigned* cnt; unsigned need; unsigned* tmo; XcdBarrier bar;
    template <class Src> __device__ __forceinline__ void run(const Src&, const pg8::Unit&, int, int, int, int) const {}
    __device__ __forceinline__ void run_final(pg8::f32x4 (&acc)[2][2][4][2], const pg8::Unit& u, int wr, int wc, int fr, int fq) const {
        using namespace pg8;
        const int row0 = u.pm * BM + wr * 64 + fr, col0 = u.pn * BM + wc * 32 + 4 * fq;
        { float rsv[2][4]; row_scales(ssq, inv_w, row0, rsv);
#pragma unroll
          for (int ai = 0; ai < 2; ++ai) {
            u32x2 hw[4][2][2], pj[4][2][2];
#pragma unroll
            for (int m = 0; m < 4; ++m)
#pragma unroll
                for (int bj = 0; bj < 2; ++bj)
#pragma unroll
                    for (int n = 0; n < 2; ++n) { const size_t o = (size_t)(row0 + ai * HALF + m * 16) * DM + col0 + bj * HALF + n * 16; hw[m][bj][n] = *(const u32x2*)(hb + o); pj[m][bj][n] = *(const u32x2*)(proj + o); }
#pragma unroll
            for (int m = 0; m < 4; ++m) { const int row = row0 + ai * HALF + m * 16; const float r = rsv[ai][m]; float s = 0.f;
#pragma unroll
                for (int bj = 0; bj < 2; ++bj)
#pragma unroll
                    for (int n = 0; n < 2; ++n) { const u32x2 w = hw[m][bj][n], p = pj[m][bj][n]; const f32x4 b = (f32x4){bf_lo(w.x), bf_hi(w.x), bf_lo(w.y), bf_hi(w.y)};
                        const f32x4 g = acc[ai][bj][m][n] * r; f32x4 v;
                        v[0] = b[0] + sigmoidf_(g[0]) * bf_lo(p.x); v[1] = b[1] + sigmoidf_(g[1]) * bf_hi(p.x); v[2] = b[2] + sigmoidf_(g[2]) * bf_lo(p.y); v[3] = b[3] + sigmoidf_(g[3]) * bf_hi(p.y);
                        acc[ai][bj][m][n] = v; s += dot4(v); }
                s += __shfl_xor(s, 16); s += __shfl_xor(s, 32); if (fq == 0) atomicAdd(ssq4 + row, s); }
          } }
        if (mode == 0) xcd_local_barrier(cnt, 32u, tmo);
        else if (mode == 1) xcd_barrier(bar);
        else { publish_count(cnt); wait_count(cnt, need, tmo); }
        float r4[2][4]; row_scales(ssq4, inv_w, row0, r4);
        f32x4 gv[2][2];
#pragma unroll
        for (int bj = 0; bj < 2; ++bj)
#pragma unroll
            for (int n = 0; n < 2; ++n) gv[bj][n] = *(const f32x4*)(gfin + col0 + bj * HALF + n * 16);
#pragma unroll
        for (int ai = 0; ai < 2; ++ai)
#pragma unroll
            for (int m = 0; m < 4; ++m) { float* yr = y + (size_t)(row0 + ai * HALF + m * 16) * DM + col0; const float r = r4[ai][m];
#pragma unroll
                for (int bj = 0; bj < 2; ++bj)
#pragma unroll
                    for (int n = 0; n < 2; ++n) __builtin_nontemporal_store(acc[ai][bj][m][n] * r * gv[bj][n], (f32x4*)(yr + bj * HALF + n * 16)); }
    }
};

struct Args { const float* in[25]; float* out; unsigned char* ws; int ph_lo, ph_hi; };
__global__ void __launch_bounds__(NWAVES * 64, 2) hymba_fwd(Args args) {
    extern __shared__ __attribute__((aligned(16))) unsigned char lds[];
    Frame F;
    F.lds = (LAS unsigned char*)lds;
    F.MISC = (volatile LAS unsigned*)(F.lds + MISC_OFF);
    F.tid = threadIdx.x; F.lane = F.tid & 63; F.wave = __builtin_amdgcn_readfirstlane(F.tid >> 6);
    F.G = gridDim.x; { const int bx = blockIdx.x; F.vcu = (F.G % 8 == 0) ? (bx % 8) * (F.G / 8) + bx / 8 : bx; }
    unsigned char* ws = args.ws;
    F.ctl = (unsigned*)(ws + WS_CTL); F.ws = ws;
#pragma unroll
    for (int i = 0; i < 25; ++i) F.in[i] = args.in[i];
    F.out = args.out;
    F.W1C = (bf16*)(ws + WS_W1C); F.W1D = (bf16*)(ws + WS_W1D); F.WIN = (bf16*)(ws + WS_WIN); F.WOUT = (bf16*)(ws + WS_WOUT); F.W2C = (bf16*)(ws + WS_W2C); F.W2D = (bf16*)(ws + WS_W2D);
    F.WPG = (bf16*)(ws + WS_WPG); F.WPP = (bf16*)(ws + WS_WPP); F.WPOOL = (bf16*)(ws + WS_WPOOL);
    F.HB = (bf16*)(ws + WS_HB); F.GB = (bf16*)(ws + WS_G); F.QB = (bf16*)(ws + WS_QB); F.KB = (bf16*)(ws + WS_KB); F.VB = (bf16*)(ws + WS_VB); F.PLB = (bf16*)(ws + WS_PLB);
    F.CB = (bf16*)(ws + WS_C); F.PROJ = (bf16*)(ws + WS_PROJ); F.PB = (bf16*)(ws + WS_PB); F.XP = (bf16*)(ws + WS_XP);
    { float* sq = (float*)(F.ctl + CW_SSQ); F.ssq0 = sq; F.ssq1 = sq + SSQ_STRIDE; F.ssqA = sq + 2 * SSQ_STRIDE; F.ssqP = sq + 3 * SSQ_STRIDE; F.ssq2 = sq + 4 * SSQ_STRIDE; F.ssq3 = sq + 5 * SSQ_STRIDE; F.ssq4 = sq + 6 * SSQ_STRIDE; }
    for (int u = F.tid; u < (LDS_BYTES - LDSCTL_OFF) / 4; u += NWAVES * 64) ((LAS unsigned*)(F.lds + LDSCTL_OFF))[u] = 0u;
    __syncthreads();
    const unsigned xcc = xb_xcc_id();
    if (F.tid == 0) F.MISC[20] = __hip_atomic_fetch_add(F.ctl + CW_RANK + 64 * xcc, 1u, __ATOMIC_RELAXED, __HIP_MEMORY_SCOPE_AGENT);
    XcdBarrier bar; bar.bar = (unsigned*)(F.ctl + CW_BAR); bar.x = 0; bar.st = nullptr;
    if (N_LAUNCHES != PER_PHASE) bar = xcd_barrier_post((unsigned*)(F.ctl + CW_BAR), F.MISC + 8);
#define GRID_BAR() do { if (N_LAUNCHES != PER_PHASE) xcd_barrier(bar); } while (0)
    const int lo = args.ph_lo, hi = args.ph_hi;
#define IN(k) (lo <= (k) && (k) < hi)
#define BOTH(k) (IN(k) && IN((k) + 1))
    float* const H = F.out + OFF_Y;
    const float inv_d = 1.0f / DM, inv_s = 1.0f / SBW;
    const int gw = F.vcu * NWAVES + F.wave, NGW = F.G * NWAVES;

    if (IN(0)) { p0_prologue(F); if (BOTH(0)) GRID_BAR(); }
    bool local_ok = false; int cdyn = (int)blockIdx.x;
    if (N_LAUNCHES != PER_PHASE && !FORCE_GRID_SEAMS) {
        if (F.tid == 0) { unsigned good = (F.G == 256) ? 1u : 0u;
#pragma unroll
            for (int q = 0; q < 16; ++q) { const unsigned c_ = __hip_atomic_load(F.ctl + CW_RANK + 64 * q, __ATOMIC_RELAXED, __HIP_MEMORY_SCOPE_AGENT); if (c_ != (q < 8 ? 32u : 0u)) good = 0u; }
            F.MISC[21] = good; }
        __syncthreads();
        local_ok = F.MISC[21] != 0u;
        if (local_ok) cdyn = (int)F.MISC[20] * 8 + (int)xcc;
    }
    unsigned* const lcnt = F.ctl + CW_RANK + 1024 + 64 * (local_ok ? xcc : 0u);
#define SEAM() do { if (N_LAUNCHES != PER_PHASE) { if (local_ok) xcd_local_barrier(lcnt, 32u, F.ctl + CW_CNT + 512); else xcd_barrier(bar); } } while (0)

    const int xg = cdyn % 8, jg = cdyn / 8;
    const int n1 = (xg < 4) ? 4 : 3;
    const bool s1_on = jg < n1 + 2; const int s1_pn = (xg < 4) ? xg * 6 + jg : 24 + (xg - 4) * 5 + jg;
    unsigned* const cnt = F.ctl + CW_CNT;
    unsigned* const tmo = F.ctl + CW_CNT + 512;
#define GEMM_CALL(EPI, SCHED, g, S, E) pg8::gemm_phase<EPI, SCHED>(F.lds + RING_OFF, g, S, E)
#define PG8_COMMA(a, b) pg8::EpiRes<a, b>
    int one = 1, two = 2, zero = 0; asm volatile("" : "+s"(one), "+s"(two), "+s"(zero));

    if (IN(1)) {
        const pg8::Gemm g1{F.HB, F.W1C, M, NCAT, DM, DM, DM, 0}; const pg8::EpiSwiGLU E1{F.GB, F.ssq0, inv_d};
        pg8::SkewOrder K1; K1.init(MP, NCAT, DM, F.G, cdyn, 0, 4); K1.lo[0] = 2 + n1; K1.lo[1] = 1; K1.lo[2] = 1; K1.lo[3] = 1; K1.lo[4] = 2; K1.lo[5] = 0;
        { pg8::OneTile S{32, s1_pn, DM / 64, s1_on ? one : zero}; GEMM_CALL(pg8::EpiSwiGLU, pg8::OneTile, g1, S, E1); if (s1_on) publish_count(cnt + 0); }
        GEMM_CALL(pg8::EpiSwiGLU, pg8::SkewOrder, g1, K1, E1);
        if (jg == 0) { wait_count(cnt + 0, 44u, tmo);
            pg8::Gemm g{F.GB, F.W1D, M, DM, FF, FF, FF, 0}; pg8::OneTile S{32, xg, FF / 64, one};
            pg8::EpiRes<false, true> E{nullptr, nullptr, F.HB, F.HB, F.ssq1, nullptr, 0.f, 0.5f, nullptr, nullptr, 0.f, nullptr, nullptr, nullptr};
            GEMM_CALL(PG8_COMMA(false, true), pg8::OneTile, g, S, E); publish_count(cnt + 64); }
        if (jg < 2) { wait_count(cnt + 64, 8u, tmo);
            pg8::Gemm g{F.HB, F.WIN, M, NIN, DM, DM, DM, 0}; pg8::OneTile S{32, jg * 8 + xg, DM / 64, one};
            pg8::EpiIn E{F.ssq1, inv_d, F.QB, F.KB, F.VB, F.XP, F.out}; GEMM_CALL(pg8::EpiIn, pg8::OneTile, g, S, E); }
        K1.r0 = 4; K1.r1 = 6; GEMM_CALL(pg8::EpiSwiGLU, pg8::SkewOrder, g1, K1, E1);
        { pg8::Gemm g{F.PB, F.WPP, M, DM, PLE, PLE, PLE, 0}; pg8::OneTile S{32, xg, PLE / 64, jg == 31 ? one : zero};
          pg8::EpiBf E{F.PROJ, DM, 0, nullptr}; GEMM_CALL(pg8::EpiBf, pg8::OneTile, g, S, E); }
        if (BOTH(1)) SEAM();
    }
    if (IN(2)) {
        pg8::Gemm g{F.GB, F.W1D, M, DM, FF, FF, FF, 0}; pg8::StaticOrder S; S.init(MP, DM, FF, F.G, cdyn);
        pg8::EpiRes<false, true> E{nullptr, nullptr, F.HB, F.HB, F.ssq1, nullptr, 0.f, 0.5f, nullptr, nullptr, 0.f, nullptr, nullptr, nullptr};
        GEMM_CALL(PG8_COMMA(false, true), pg8::StaticOrder, g, S, E);
        if (BOTH(2)) SEAM();
    }
    if (IN(3)) {
        pg8::Gemm g{F.HB, F.WIN, M, NIN, DM, DM, DM, 0}; pg8::StaticOrder S; S.init(MP, NIN, DM, F.G, cdyn);
        pg8::EpiIn E{F.ssq1, inv_d, F.QB, F.KB, F.VB, F.XP, F.out}; GEMM_CALL(pg8::EpiIn, pg8::StaticOrder, g, S, E);
        if (BOTH(3)) GRID_BAR();
    }
    if (IN(4)) {
        LAS unsigned char* vl = F.lds + RING_OFF + F.wave * VIMG_BYTES;
        constexpr int NU_S = DECB * NH, NU_P = BATCH * NH * (SEQ / 32);
        { const bool is_s = (F.wave == 0 && F.vcu < NU_S);
          const int nsb = (F.vcu < NU_S ? F.vcu : NU_S) + ((F.wave > 0 && F.vcu < NU_S) ? 1 : 0);
          const int idx = gw - nsb;
          if (is_s) sb_unit<true>(F, F.vcu / NH, F.vcu % NH, 0, vl);
          else {
              { const int k = idx, qblk = (SEQ / 32 - 1) - k / (BATCH * NH), bh = k % (BATCH * NH); sb_unit<false>(F, bh / NH, bh % NH, qblk, vl); }
              if (F.vcu >= 196 && F.vcu < 204) { const int k = (NGW - NU_S) + (F.vcu - 196) * NWAVES + F.wave, qblk = (SEQ / 32 - 1) - k / (BATCH * NH), bh = k % (BATCH * NH); sb_unit<false>(F, bh / NH, bh % NH, qblk, vl); }
          } }
        const int pb = F.vcu - 64;
        if (pb >= 0 && pb < 132) {
            const bool smp = pb >= 128; const int pm = smp ? 32 : (pb >> 2), g = smp ? pb - 128 : (pb & 3);
            if (smp) pool_unit(F, 1024 + F.wave * 4 + g);
            else pool_unit(F, ((pm >> 3) << 8) | (g << 6) | ((pm & 7) * 8 + F.wave));
            VM_WAIT(); __syncthreads();
            if (F.tid == 0) { __builtin_amdgcn_fence(__ATOMIC_ACQUIRE, "agent"); VM_WAIT(); }
            __syncthreads();
            pg8::Gemm g5{F.PLB, F.WPOOL, M, PWID, 256, PWID, 256, 256}; pg8::EpiBf E5{F.CB, DM, SBW, F.ssqP};
            pg8::OneTile S{pm, g, 256 / 64, one}; GEMM_CALL(pg8::EpiBf, pg8::OneTile, g5, S, E5);
        }
        if (BOTH(4)) GRID_BAR();
    }
    if (IN(6)) {
        pg8::Gemm g{F.CB, F.WOUT, M, DM, DM, DM, DM, 0}; pg8::HalvesOrder S; S.init(MP, DM, DM, F.G, cdyn);
        pg8::EpiRes<true, true> E{nullptr, nullptr, F.HB, F.HB, F.ssq2, F.ssqP, inv_s, 1.0f, F.ssqA, F.ssqP, inv_s, nullptr, nullptr, nullptr};
        GEMM_CALL(PG8_COMMA(true, true), pg8::HalvesOrder, g, S, E);
        if (BOTH(6)) SEAM();
    }
    if (IN(7)) {
        const pg8::Gemm g5{F.HB, F.W2C, M, NCAT, DM, DM, DM, 0}; const pg8::EpiSwiGLU E5{F.GB, F.ssq2, inv_d};
        pg8::SkewOrder K5; K5.init(MP, NCAT, DM, F.G, cdyn, 0, 1); K5.lo[0] = 1; K5.lo[1] = n1 + 2; K5.lo[2] = 1; K5.lo[3] = 1; K5.lo[4] = 1; K5.lo[5] = 1; K5.hi[0] = 31; K5.hi[2] = 31; K5.hi[3] = 31;
        if (jg == 31) { pg8::Gemm g{F.CB, F.WOUT, M, DM, DM, DM, DM, 0}; pg8::OnePiece S{32, xg, 16, 16, one}; pg8::EpiRaw E{(float*)(ws + WS_SLAB + 2 * MiB)};
            GEMM_CALL(pg8::EpiRaw, pg8::OnePiece, g, S, E); publish_count(cnt + 1536 + 64 * xg); }
        if (jg == 0) { pg8::Gemm g{F.CB, F.WOUT, M, DM, DM, DM, DM, 0}; pg8::OnePiece S{32, xg, zero, 16, one};
            pg8::EpiRes<false, true, true, true> E{nullptr, nullptr, F.HB, F.HB, F.ssq2, F.ssqP, inv_s, 1.0f, F.ssqA, F.ssqP, inv_s, (const float*)(ws + WS_SLAB + 2 * MiB), cnt + 1536 + 64 * xg, tmo};
            pg8::gemm_phase<pg8::EpiRes<false, true, true, true>, pg8::OnePiece>(F.lds + RING_OFF, g, S, E); publish_count(cnt + 128); }
        GEMM_CALL(pg8::EpiSwiGLU, pg8::SkewOrder, g5, K5, E5);
        if (s1_on) { wait_count(cnt + 128, 8u, tmo); pg8::OneTile S{32, s1_pn, DM / 64, one}; GEMM_CALL(pg8::EpiSwiGLU, pg8::OneTile, g5, S, E5); publish_count(cnt + 192); }
        K5.r0 = 1; K5.r1 = 2; GEMM_CALL(pg8::EpiSwiGLU, pg8::SkewOrder, g5, K5, E5);
        if (jg == 31) { wait_count(cnt + 192, 44u, tmo);
            pg8::Gemm g{F.GB, F.W2D, M, DM, FF, FF, FF, 0}; pg8::OnePiece S{32, xg, 44, 44, one}; pg8::EpiRaw E{(float*)(ws + WS_SLAB)};
            GEMM_CALL(pg8::EpiRaw, pg8::OnePiece, g, S, E); publish_count(cnt + 1024 + 64 * xg); }
        if (jg == 0) { wait_count(cnt + 192, 44u, tmo);
            pg8::Gemm g{F.GB, F.W2D, M, DM, FF, FF, FF, 0}; pg8::OnePiece S{32, xg, zero, 44, one};
            pg8::EpiRes<false, true, true> E{nullptr, nullptr, F.HB, F.HB, F.ssq3, nullptr, 0.f, 0.5f, nullptr, nullptr, 0.f, (const float*)(ws + WS_SLAB), cnt + 1024 + 64 * xg, tmo};
            pg8::gemm_phase<pg8::EpiRes<false, true, true>, pg8::OnePiece>(F.lds + RING_OFF, g, S, E); publish_count(cnt + 256); }
        if (jg == 0) { wait_count(cnt + 256, 8u, tmo);
            pg8::Gemm g{F.HB, F.WPG, M, DM, DM, DM, DM, 0}; pg8::OneTile S{32, xg, DM / 64, one};
            EpiPleFinal E{H, F.HB, F.PROJ, F.ssq3, inv_d, F.ssq4, F.in[I_GFINAL], 2, cnt + 320, 8u, tmo, bar}; GEMM_CALL(EpiPleFinal, pg8::OneTile, g, S, E); }
        K5.r0 = 2; K5.r1 = 6; GEMM_CALL(pg8::EpiSwiGLU, pg8::SkewOrder, g5, K5, E5);
        if (BOTH(7)) SEAM();
    }
    if (IN(8)) {
        pg8::Gemm g{F.GB, F.W2D, M, DM, FF, FF, FF, 0}; pg8::StaticOrder S; S.init(MP, DM, FF, F.G, cdyn);
        pg8::EpiRes<false, true> E{nullptr, nullptr, F.HB, F.HB, F.ssq3, nullptr, 0.f, 0.5f, nullptr, nullptr, 0.f, nullptr, nullptr, nullptr};
        GEMM_CALL(PG8_COMMA(false, true), pg8::StaticOrder, g, S, E);
        if (BOTH(8)) SEAM();
    }
    if (IN(9)) {
        { pg8::Gemm gp{F.PB, F.WPP, M, DM, PLE, PLE, PLE, 0}; pg8::StaticOrder Sp; Sp.init(MP, DM, PLE, F.G, cdyn);
          pg8::EpiBf Ep{F.PROJ, DM, 0, nullptr}; GEMM_CALL(pg8::EpiBf, pg8::StaticOrder, gp, Sp, Ep); }
        pg8::Gemm g{F.HB, F.WPG, M, DM, DM, DM, DM, 0}; pg8::StaticOrder S; S.init(MP, DM, DM, F.G, cdyn);
        EpiPleFinal E{H, F.HB, F.PROJ, F.ssq3, inv_d, F.ssq4, F.in[I_GFINAL], local_ok ? 0 : 1, lcnt, 32u, tmo, bar}; GEMM_CALL(EpiPleFinal, pg8::StaticOrder, g, S, E);
    }
#undef IN
#undef BOTH
}

extern "C" void kernel_launch(void* const* d_in, const int* in_sizes, int n_in, void* d_out, int out_size, void* d_ws, size_t ws_size, hipStream_t stream) {
    static int grid = 0;
    if (grid == 0) {
        if (n_in != 25 || in_sizes[0] != MP * DM || (size_t)out_size != OUT_TOTAL || ws_size < WS_END) {
            fprintf(stderr, "kernel_launch: shape/workspace mismatch: n_in %d in0 %d out %d (want %zu) ws %zu (want %zu); nothing launched\n", n_in, n_in > 0 ? in_sizes[0] : -1, out_size, (size_t)OUT_TOTAL, ws_size, (size_t)WS_END); grid = -1; return; }
        int dev = 0, cus = 0, per_cu = 0;
        if (hipGetDevice(&dev) != hipSuccess || hipDeviceGetAttribute(&cus, hipDeviceAttributeMultiprocessorCount, dev) != hipSuccess) { fprintf(stderr, "kernel_launch: device query failed\n"); grid = -1; return; }
        if (hipFuncSetAttribute((const void*)hymba_fwd, hipFuncAttributeMaxDynamicSharedMemorySize, LDS_BYTES) != hipSuccess) { fprintf(stderr, "kernel_launch: hipFuncSetAttribute failed\n"); grid = -1; return; }
        if (hipOccupancyMaxActiveBlocksPerMultiprocessor(&per_cu, (const void*)hymba_fwd, NWAVES * 64, LDS_BYTES) != hipSuccess || per_cu < 1) { fprintf(stderr, "kernel_launch: occupancy query reports %d blocks per CU; nothing launched\n", per_cu); (void)hipGetLastError(); grid = -1; return; }
        if (cus != 256) { fprintf(stderr, "kernel_launch: the phase program deals tiles over 8 groups x 32 workgroups; this device has %d CUs; nothing launched\n", cus); grid = -1; return; }
        grid = cus;
    }
    if (grid < 0) return;
    if (hipMemsetAsync((char*)d_ws + WS_CTL, 0, CTL_ZERO_BYTES, stream) != hipSuccess) { fprintf(stderr, "kernel_launch: memset failed\n"); return; }
    Args a{};
    for (int i = 0; i < 25; ++i) a.in[i] = (const float*)d_in[i];
    a.out = (float*)d_out; a.ws = (unsigned char*)d_ws;
    if (N_LAUNCHES == 1) {
        a.ph_lo = 0; a.ph_hi = PER_PHASE;
        void* kargs[] = {&a};
        const hipError_t e = hipLaunchCooperativeKernel((const void*)hymba_fwd, dim3(grid), dim3(NWAVES * 64), kargs, LDS_BYTES, stream);
        if (e != hipSuccess) fprintf(stderr, "kernel_launch: cooperative launch failed: %s (grid %d)\n", hipGetErrorString(e), grid);
    } else {
        for (int li = 0; li < PER_PHASE; ++li) { a.ph_lo = li; a.ph_hi = li + 1;
            hipLaunchKernelGGL(hymba_fwd, dim3(grid), dim3(NWAVES * 64), LDS_BYTES, stream, a);
            const hipError_t le = hipPeekAtLastError(); if (le != hipSuccess) { fprintf(stderr, "kernel_launch: launch %d failed: %s\n", li, hipGetErrorName(le)); break; } }
    }
}
```

```cpp
#include <hip/hip_runtime.h>
#include <cstdio>
#include <cstdint>

#ifndef MK_N_LAUNCHES
#define MK_N_LAUNCHES 1
#endif
#ifndef FORCE_GRID_SEAMS
#define FORCE_GRID_SEAMS 0
#endif

constexpr int DM = 2048, FF = 5632, NCAT = 2 * FF, NIN = 4096, SBW = 1024, PWID = 1024, PLE = 256;
constexpr int BATCH = 4, SEQ = 2048, DECB = 8, DECS = 32, PAST = 2048, NH = 8, HD = 128, PSTATE = 15;
constexpr int MP = BATCH * SEQ, MS = DECB * DECS, M = MP + MS;
constexpr float RMS_EPS = 1e-6f;
constexpr float LOG2E = 1.4426950408889634f;
constexpr float QSCALE = 0.08838834764831845f * LOG2E;
constexpr size_t OFF_Y = 0;
constexpr size_t OFF_KP = (size_t)M * DM;
constexpr size_t OFF_VP = OFF_KP + (size_t)MP * SBW;
constexpr size_t OFF_PP = OFF_VP + (size_t)MP * SBW;
constexpr size_t OFF_KS = OFF_PP + (size_t)BATCH * PSTATE * PWID;
constexpr size_t OFF_VS = OFF_KS + (size_t)MS * SBW;
constexpr size_t OFF_PS = OFF_VS + (size_t)MS * SBW;
constexpr size_t OUT_TOTAL = OFF_PS + (size_t)DECB * PSTATE * PWID;

namespace pg8 {
#define PG8_LAS __attribute__((address_space(3)))
typedef unsigned short bf16_t;
typedef short bf16x8 __attribute__((ext_vector_type(8)));
typedef float f32x4 __attribute__((ext_vector_type(4)));
typedef unsigned u32x4 __attribute__((ext_vector_type(4)));
typedef unsigned u32x2 __attribute__((ext_vector_type(2)));
constexpr int BM = 256, BK = 64, HALF = 128, HTB = HALF * BK * 2, STAGE_BYTES = 8 * HTB, NXCD = 8, WGM = 4;

__host__ __device__ __forceinline__ int lds_byte(int r, int c) { const int st = (r >> 4) * 2 + (c >> 5), rr = r & 15, cc = c & 31, ob = rr * 64 + cc * 2; return st * 1024 + (ob ^ (((ob >> 9) & 1) << 5)); }
__host__ __device__ __forceinline__ void stage_rc(int b, int& R, int& C) { const int st = b / 1024, sb = b % 1024, swz = sb ^ (((sb >> 9) & 1) << 5); R = (st >> 1) * 16 + swz / 64; C = (st & 1) * 32 + (swz % 64) / 2; }

struct Unit { int pm, pn, kt0, nkt, part; };
struct Gemm { const bf16_t* A; const bf16_t* Bt; int M, N, K, lda, ldb, a_pn_off; };

__host__ __device__ __forceinline__ void tile_of(int wgid_in, int nwg, int nM, int nN, int& pm, int& pn) {
    int wgid = wgid_in; { const int q = nwg / NXCD, r = nwg % NXCD, xcd = wgid % NXCD, off = wgid / NXCD; wgid = (xcd < r ? xcd * (q + 1) : r * (q + 1) + (xcd - r) * q) + off; }
    const int nig = WGM * nN, gid = wgid / nig, fm = gid * WGM, gsz = (nM - fm) < WGM ? (nM - fm) : WGM;
    pm = fm + ((wgid % nig) % gsz); pn = (wgid % nig) / gsz;
}
struct StaticOrder {
    int nM, nN, nwg, G, c, NT;
    __host__ __device__ __forceinline__ void init(int M, int N, int K, int G_, int c_) { nM = M / BM; nN = N / BM; nwg = nM * nN; G = G_; c = c_; NT = K / BK; }
    __host__ __device__ __forceinline__ bool next(int i, Unit& u) const {
        const long L = (long)i * G + c; const bool ok = L < nwg; int pm = 0, pn = 0;
        if (ok) tile_of((int)L, nwg, nM, nN, pm, pn);
        u.pm = pm; u.pn = pn; u.kt0 = 0; u.nkt = NT; u.part = 0; return ok;
    }
    __device__ __forceinline__ void a_ready(const Unit&) const {}
    __device__ __forceinline__ void done(const Unit&) const {}
};
struct HalvesOrder {
    int nM, nN, nwg, G, c, NT;
    __host__ __device__ __forceinline__ void init(int M, int N, int K, int G_, int c_) { nM = M / BM; nN = N / BM; nwg = nM * nN; G = G_; c = c_; NT = K / BK; }
    __host__ __device__ __forceinline__ bool next(int i, Unit& u) const {
        const long L = (long)(i >> 1) * G + c; const bool ok = L < nwg; int pm = 0, pn = 0;
        if (ok) tile_of((int)L, nwg, nM, nN, pm, pn);
        const int nkt = NT >> 1;
        u.pm = pm; u.pn = pn; u.kt0 = (i & 1) * nkt; u.nkt = nkt; u.part = (i & 1) ? 0 : 2; return ok;
    }
    __device__ __forceinline__ void a_ready(const Unit&) const {}
    __device__ __forceinline__ void done(const Unit&) const {}
};
template <bool HALVES> struct OneTileT {
    int pm, pn, NT, on;
    __host__ __device__ __forceinline__ bool next(int i, Unit& u) const {
        const int nkt = HALVES ? (NT >> 1) : NT;
        u.pm = pm; u.pn = pn; u.kt0 = HALVES ? (i & 1) * nkt : 0; u.nkt = nkt; u.part = HALVES ? ((i & 1) ? 0 : 2) : 0;
        return on > i * (HALVES ? 1 : 2);
    }
    __device__ __forceinline__ void a_ready(const Unit&) const {}
    __device__ __forceinline__ void done(const Unit&) const {}
};
typedef OneTileT<false> OneTile; typedef OneTileT<true> OneTileH;
struct OnePiece {
    int pm, pn, kt0, nkt, on;
    __host__ __device__ __forceinline__ bool next(int i, Unit& u) const { u.pm = pm; u.pn = pn; u.kt0 = kt0; u.nkt = nkt; u.part = 0; return on > i * 2; }
    __device__ __forceinline__ void a_ready(const Unit&) const {}
    __device__ __forceinline__ void done(const Unit&) const {}
};
struct SkewOrder {
    int nM, nN, nwg, chunk, x, j, r0, r1, NT; int lo[6], hi[6];
    __host__ __device__ __forceinline__ void init(int M, int N, int K, int G, int c, int r0_, int r1_) { nM = M / BM; nN = N / BM; nwg = nM * nN; chunk = nwg / NXCD; x = c % NXCD; j = c / NXCD; r0 = r0_; r1 = r1_; NT = K / BK; (void)G;
#pragma unroll
        for (int r = 0; r < 6; ++r) hi[r] = 32; }
    __host__ __device__ __forceinline__ bool next(int i, Unit& u) const {
        int pre = 0, k = 0, off = -1;
#pragma unroll
        for (int r = 0; r < 6; ++r) { const bool act = j >= lo[r] && j < hi[r]; if (act && r >= r0 && r < r1) { if (k == i) off = pre + (j - lo[r]); ++k; } pre += hi[r] - lo[r]; }
        const bool ok = off >= 0 && off < chunk; int pm = 0, pn = 0;
        if (ok) { const int wgid = x * chunk + off; const int nig = WGM * nN, gid = wgid / nig, fm = gid * WGM, gsz = (nM - fm) < WGM ? (nM - fm) : WGM; pm = fm + ((wgid % nig) % gsz); pn = (wgid % nig) / gsz; }
        u.pm = pm; u.pn = pn; u.kt0 = 0; u.nkt = NT; u.part = 0; return ok;
    }
    __device__ __forceinline__ void a_ready(const Unit&) const {}
    __device__ __forceinline__ void done(const Unit&) const {}
};
typedef float f32x2 __attribute__((ext_vector_type(2)));
typedef __bf16 bf16x2_t __attribute__((ext_vector_type(2)));
__device__ __forceinline__ unsigned pk2(float lo, float hi) { f32x2 v = {lo, hi}; bf16x2_t b = __builtin_convertvector(v, bf16x2_t); return __builtin_bit_cast(unsigned, b); }
__device__ __forceinline__ u32x2 pk4(f32x4 v) { u32x2 w; w.x = pk2(v[0], v[1]); w.y = pk2(v[2], v[3]); return w; }
__device__ __forceinline__ float bf_lo(unsigned w) { return __uint_as_float(w << 16); }
__device__ __forceinline__ float bf_hi(unsigned w) { return __uint_as_float(w & 0xffff0000u); }
__device__ __forceinline__ float rs_of(float ssq, float inv_w) { return __builtin_amdgcn_rsqf(ssq * inv_w + RMS_EPS); }
__device__ __forceinline__ float sigmoidf_(float g) { return __builtin_amdgcn_rcpf(1.0f + __builtin_amdgcn_exp2f(-g * LOG2E)); }
__device__ __forceinline__ float dot4(f32x4 v) { return (v[0] * v[0] + v[1] * v[1]) + (v[2] * v[2] + v[3] * v[3]); }

__device__ __forceinline__ void row_scales(const float* ssq, float inv_w, int row0, float (&rsv)[2][4]) {
    float q[2][4];
#pragma unroll
    for (int ai = 0; ai < 2; ++ai)
#pragma unroll
        for (int m = 0; m < 4; ++m) q[ai][m] = ssq[row0 + ai * HALF + m * 16];
#pragma unroll
    for (int ai = 0; ai < 2; ++ai)
#pragma unroll
        for (int m = 0; m < 4; ++m) rsv[ai][m] = rs_of(q[ai][m], inv_w);
}

struct AccSrc { const f32x4 (&acc)[2][2][4][2]; __device__ __forceinline__ f32x4 operator()(int ai, int bj, int m, int n) const { return acc[ai][bj][m][n]; } };
struct EpiSwiGLU {
    static constexpr bool AFTER_DRAIN = false, MID = false, FINAL = false;
    bf16_t* G; const float* ssq; float inv_w;
    template <class Src> __device__ __forceinline__ void run(const Src& src, const Unit& u, int wr, int wc, int fr, int fq) const {
        const int row0 = u.pm * BM + wr * 64 + fr, col0 = u.pn * HALF + wc * 32 + 4 * fq;
        float rsv[2][4]; row_scales(ssq, inv_w, row0, rsv);
#pragma unroll
        for (int ai = 0; ai < 2; ++ai)
#pragma unroll
            for (int m = 0; m < 4; ++m) { const int row = row0 + ai * HALF + m * 16; const float r = rsv[ai][m]; bf16_t* rowp = G + (size_t)row * FF + col0;
#pragma unroll
                for (int n = 0; n < 2; ++n) { const f32x4 g = src(ai, 0, m, n) * r, up = src(ai, 1, m, n) * r; f32x4 v;
#pragma unroll
                    for (int i = 0; i < 4; ++i) v[i] = g[i] * sigmoidf_(g[i]) * up[i];
                    *(u32x2*)(rowp + n * 16) = pk4(v); }
                if (m & 1) asm volatile("" ::: "memory"); }
    }
};
struct EpiBf {
    static constexpr bool AFTER_DRAIN = false, MID = false, FINAL = false;
    bf16_t* O; int ldc, col_base; float* ssq_out;
    template <class Src> __device__ __forceinline__ void run(const Src& src, const Unit& u, int wr, int wc, int fr, int fq) const {
        const int row0 = u.pm * BM + wr * 64 + fr, col0 = col_base + u.pn * BM + wc * 32 + 4 * fq;
#pragma unroll
        for (int ai = 0; ai < 2; ++ai)
#pragma unroll
            for (int m = 0; m < 4; ++m) { const int row = row0 + ai * HALF + m * 16; bf16_t* rowp = O + (size_t)row * ldc + col0; float s = 0.f;
#pragma unroll
                for (int bj = 0; bj < 2; ++bj)
#pragma unroll
                    for (int n = 0; n < 2; ++n) { const f32x4 v = src(ai, bj, m, n); *(u32x2*)(rowp + bj * HALF + n * 16) = pk4(v); s += dot4(v); }
                if (ssq_out) { s += __shfl_xor(s, 16); s += __shfl_xor(s, 32); if (fq == 0) atomicAdd(ssq_out + row, s); }
                if (m & 1) asm volatile("" ::: "memory"); }
    }
};
struct EpiRaw {
    static constexpr bool AFTER_DRAIN = false, MID = false, FINAL = false;
    float* slab;
    template <class Src> __device__ __forceinline__ void run(const Src& src, const Unit& u, int wr, int wc, int fr, int fq) const {
        float* t = slab + (size_t)u.pn * 65536 + (size_t)(wr * 64 + fr) * 256 + wc * 32 + 4 * fq;
#pragma unroll
        for (int ai = 0; ai < 2; ++ai)
#pragma unroll
            for (int m = 0; m < 4; ++m)
#pragma unroll
                for (int bj = 0; bj < 2; ++bj)
#pragma unroll
                    for (int n = 0; n < 2; ++n) *(f32x4*)(t + (ai * HALF + m * 16) * 256 + bj * HALF + n * 16) = src(ai, bj, m, n);
    }
};
template <bool HAS_MID, bool BASE_BF16, bool ADD_SLAB = false, bool PRE_SCALE = false> struct EpiRes {
    static constexpr bool AFTER_DRAIN = false, MID = HAS_MID, FINAL = false;
    const float* base0; const float* base1;
    const bf16_t* baseb; bf16_t* outb; float* ssq_out;
    const float* ssq_rs; float inv_w_rs, alpha;
    const float* ssq_a; const float* ssq_p; float inv_w_mid;
    const float* slab; unsigned* flag; unsigned* tmo;
    __device__ __forceinline__ float midf(int row) const { return __builtin_amdgcn_sqrtf((ssq_p[row] * inv_w_mid + RMS_EPS) * __builtin_amdgcn_rcpf(ssq_a[row] * inv_w_mid + RMS_EPS)); }
    __device__ __forceinline__ void mid(f32x4 (&acc)[2][2][4][2], const Unit& u, int wr, int wc, int fr, int fq) const {
        const int row0 = u.pm * BM + wr * 64 + fr;
        float qa[2][4], qp[2][4];
#pragma unroll
        for (int ai = 0; ai < 2; ++ai)
#pragma unroll
            for (int m = 0; m < 4; ++m) { const int row = row0 + ai * HALF + m * 16; qa[ai][m] = ssq_a[row]; qp[ai][m] = ssq_p[row]; }
#pragma unroll
        for (int ai = 0; ai < 2; ++ai)
#pragma unroll
            for (int m = 0; m < 4; ++m) { const float f = __builtin_amdgcn_sqrtf((qp[ai][m] * inv_w_mid + RMS_EPS) * __builtin_amdgcn_rcpf(qa[ai][m] * inv_w_mid + RMS_EPS));
#pragma unroll
                for (int bj = 0; bj < 2; ++bj)
#pragma unroll
                    for (int n = 0; n < 2; ++n) acc[ai][bj][m][n] *= f; }
    }
    template <class Src> __device__ __forceinline__ void run(const Src& src, const Unit& u, int wr, int wc, int fr, int fq) const {
        const int row0 = u.pm * BM + wr * 64 + fr, col0 = u.pn * BM + wc * 32 + 4 * fq;
        const float* base = (u.pm * BM < MP) ? base0 : base1;
        const float* pt = nullptr;
        float scv[2][4];
        if (ssq_rs) { row_scales(ssq_rs, inv_w_rs, row0, scv);
#pragma unroll
            for (int ai = 0; ai < 2; ++ai)
#pragma unroll
                for (int m = 0; m < 4; ++m) scv[ai][m] *= alpha; }
        else {
#pragma unroll
            for (int ai = 0; ai < 2; ++ai)
#pragma unroll
                for (int m = 0; m < 4; ++m) scv[ai][m] = alpha; }
        if constexpr (ADD_SLAB) {
            if (threadIdx.x == 0) { unsigned sp = 0;
                while (__hip_atomic_load(flag, __ATOMIC_RELAXED, __HIP_MEMORY_SCOPE_AGENT) == 0u) { __builtin_amdgcn_s_sleep(8); if (++sp > (1u << 22)) { atomicAdd(tmo, 1u); break; } }
                __builtin_amdgcn_fence(__ATOMIC_ACQUIRE, "agent"); asm volatile("s_waitcnt vmcnt(0)" ::: "memory"); }
            asm volatile("" ::: "memory"); __builtin_amdgcn_s_barrier(); asm volatile("" ::: "memory");
            pt = slab + (size_t)u.pn * 65536 + (size_t)(wr * 64 + fr) * 256 + wc * 32 + 4 * fq; }
#pragma unroll
        for (int ai = 0; ai < 2; ++ai) {
            u32x2 bw[4][2][2];
            if constexpr (BASE_BF16) {
#pragma unroll
                for (int m = 0; m < 4; ++m)
#pragma unroll
                    for (int bj = 0; bj < 2; ++bj)
#pragma unroll
                        for (int n = 0; n < 2; ++n) bw[m][bj][n] = *(const u32x2*)(baseb + (size_t)(row0 + ai * HALF + m * 16) * DM + col0 + bj * HALF + n * 16); }
#pragma unroll
            for (int m = 0; m < 4; ++m) { const int row = row0 + ai * HALF + m * 16; const size_t off = (size_t)row * DM + col0;
                const float sc = scv[ai][m]; float s = 0.f; float pre = 1.0f; if constexpr (PRE_SCALE) pre = midf(row);
                f32x4 sl[2][2];
                if constexpr (ADD_SLAB) {
#pragma unroll
                    for (int bj = 0; bj < 2; ++bj)
#pragma unroll
                        for (int n = 0; n < 2; ++n) sl[bj][n] = *(const f32x4*)(pt + (ai * HALF + m * 16) * 256 + bj * HALF + n * 16); }
#pragma unroll
                for (int bj = 0; bj < 2; ++bj)
#pragma unroll
                    for (int n = 0; n < 2; ++n) { const int co = bj * HALF + n * 16; f32x4 b;
                        if constexpr (BASE_BF16) { const u32x2 w = bw[m][bj][n]; b = (f32x4){bf_lo(w.x), bf_hi(w.x), bf_lo(w.y), bf_hi(w.y)}; }
                        else b = *(const f32x4*)(base + off + co);
                        f32x4 a4 = src(ai, bj, m, n); if constexpr (PRE_SCALE) a4 *= pre; if constexpr (ADD_SLAB) a4 += sl[bj][n];
                        const f32x4 v = b + a4 * sc;
                        *(u32x2*)(outb + off + co) = pk4(v); s += dot4(v); }
                s += __shfl_xor(s, 16); s += __shfl_xor(s, 32); if (fq == 0) atomicAdd(ssq_out + row, s);
                if (m & 1) asm volatile("" ::: "memory"); }
        }
    }
};
struct EpiIn {
    static constexpr bool AFTER_DRAIN = false, MID = false, FINAL = false;
    const float* ssq; float inv_w; bf16_t *qb, *kb, *vb, *xp; float* out;
    template <class Src> __device__ __forceinline__ void run(const Src& src, const Unit& u, int wr, int wc, int fr, int fq) const {
        const int row0 = u.pm * BM + wr * 64 + fr, seg = u.pn >> 2, cseg = (u.pn & 3) * BM + wc * 32 + 4 * fq;
        const bool prompt = u.pm * BM < MP;
        float rsv[2][4]; row_scales(ssq, inv_w, row0, rsv);
#pragma unroll
        for (int ai = 0; ai < 2; ++ai)
#pragma unroll
            for (int m = 0; m < 4; ++m) { const int row = row0 + ai * HALF + m * 16; const float r = rsv[ai][m]; const size_t off = (size_t)row * SBW + cseg;
                float* fo = nullptr; float* po = nullptr;
                if (seg == 1) fo = prompt ? out + OFF_KP + off : out + OFF_KS + ((size_t)(row - MP) * SBW + cseg);
                if (seg == 2) fo = prompt ? out + OFF_VP + off : out + OFF_VS + ((size_t)(row - MP) * SBW + cseg);
                if (seg == 3) { if (prompt) { const int b = row / SEQ, t = row % SEQ; if (t >= SEQ - PSTATE) po = out + OFF_PP + ((size_t)(b * PSTATE + t - (SEQ - PSTATE)) * PWID + cseg); }
                                else { const int rs_ = row - MP, b = rs_ / DECS, t = rs_ % DECS; if (t >= DECS - PSTATE) po = out + OFF_PS + ((size_t)(b * PSTATE + t - (DECS - PSTATE)) * PWID + cseg); } }
#pragma unroll
                for (int bj = 0; bj < 2; ++bj)
#pragma unroll
                    for (int n = 0; n < 2; ++n) { const int co = bj * HALF + n * 16; const f32x4 v = src(ai, bj, m, n) * r;
                        if (seg == 0) *(u32x2*)(qb + off + co) = pk4(v * QSCALE);
                        else if (seg == 1) { *(u32x2*)(kb + off + co) = pk4(v); __builtin_nontemporal_store(v, (f32x4*)(fo + co)); }
                        else if (seg == 2) { *(u32x2*)(vb + off + co) = pk4(v); __builtin_nontemporal_store(v, (f32x4*)(fo + co)); }
                        else { *(u32x2*)(xp + off + co) = pk4(v); if (po) *(f32x4*)(po + co) = v; } }
                if (m & 1) asm volatile("" ::: "memory"); }
    }
};
struct EpiPle {
    static constexpr bool AFTER_DRAIN = false, MID = false, FINAL = false;
    bf16_t* h; const bf16_t* hb; const bf16_t* proj; const float* ssq; float inv_w; float* ssq_out;
    template <class Src> __device__ __forceinline__ void run(const Src& src, const Unit& u, int wr, int wc, int fr, int fq) const {
        const int row0 = u.pm * BM + wr * 64 + fr, col0 = u.pn * BM + wc * 32 + 4 * fq;
        float rsv[2][4]; row_scales(ssq, inv_w, row0, rsv);
#pragma unroll
        for (int ai = 0; ai < 2; ++ai) {
            u32x2 hw[4][2][2], pj[4][2][2];
#pragma unroll
            for (int m = 0; m < 4; ++m)
#pragma unroll
                for (int bj = 0; bj < 2; ++bj)
#pragma unroll
                    for (int n = 0; n < 2; ++n) { const size_t o = (size_t)(row0 + ai * HALF + m * 16) * DM + col0 + bj * HALF + n * 16; hw[m][bj][n] = *(const u32x2*)(hb + o); pj[m][bj][n] = *(const u32x2*)(proj + o); }
#pragma unroll
            for (int m = 0; m < 4; ++m) { const int row = row0 + ai * HALF + m * 16; const size_t off = (size_t)row * DM + col0; const float r = rsv[ai][m]; float s = 0.f;
#pragma unroll
                for (int bj = 0; bj < 2; ++bj)
#pragma unroll
                    for (int n = 0; n < 2; ++n) { const int co = bj * HALF + n * 16; const u32x2 w = hw[m][bj][n], p = pj[m][bj][n]; const f32x4 b = (f32x4){bf_lo(w.x), bf_hi(w.x), bf_lo(w.y), bf_hi(w.y)};
                        const f32x4 g = src(ai, bj, m, n) * r; f32x4 v;
                        v[0] = b[0] + sigmoidf_(g[0]) * bf_lo(p.x); v[1] = b[1] + sigmoidf_(g[1]) * bf_hi(p.x); v[2] = b[2] + sigmoidf_(g[2]) * bf_lo(p.y); v[3] = b[3] + sigmoidf_(g[3]) * bf_hi(p.y);
                        *(u32x2*)(h + off + co) = pk4(v); s += dot4(v); }
                s += __shfl_xor(s, 16); s += __shfl_xor(s, 32); if (fq == 0) atomicAdd(ssq_out + row, s);
                if (m & 1) asm volatile("" ::: "memory"); }
        }
    }
};

template <class Epi, class Sched, bool ALIGN_EPI = true>
__device__ __forceinline__ void gemm_phase(PG8_LAS unsigned char* lds, const Gemm g, const Sched& S, const Epi& E) {
    const int tid = threadIdx.x, wid = __builtin_amdgcn_readfirstlane(tid >> 6), lane = tid & 63, wr = wid >> 2, wc = wid & 3, fr = lane & 15, fq = lane >> 4;
    int K_ = g.K; asm volatile("" : "+s"(K_));
    const int K = K_, nt = K / BK;
    unsigned voffA[2], voffB[2];
#pragma unroll
    for (int i = 0; i < 2; ++i) { int R, C; stage_rc(tid * 16 + i * 8192, R, C); voffA[i] = (unsigned)(R * g.lda + C) * 2u; voffB[i] = (unsigned)(R * g.ldb + C) * 2u; }
    const size_t kstep = (size_t)(BK * 2);
    const size_t hstepA = (size_t)HALF * g.lda * 2, hstepB = (size_t)HALF * g.ldb * 2;
    const size_t tstepA = 2 * hstepA, tstepB = 2 * hstepB;
    const unsigned ldsw = (unsigned)wid * 1024u;
    const int aoff = lds_byte(wr * 64 + fr, fq * 8), boff = lds_byte(wc * 32 + fr, fq * 8);
#define PG8_SA(b, h) (((b) * 2 + (h)) * HTB)
#define PG8_SB(b, h) ((4 + (b) * 2 + (h)) * HTB)
#define PG8_STAGE(bufoff, gbase, voff) do { _Pragma("unroll") for (int _i = 0; _i < 2; ++_i) \
        __builtin_amdgcn_global_load_lds((const unsigned*)((const char*)(gbase) + (voff)[_i]), (PG8_LAS unsigned*)(lds + (bufoff) + ldsw + _i * 8192), 16, 0, 0); } while (0)
#define PG8_LDA(dst, b, h) do { _Pragma("unroll") for (int m = 0; m < 4; ++m) _Pragma("unroll") for (int k = 0; k < 2; ++k) dst[m][k] = *(const PG8_LAS bf16x8*)(lds + PG8_SA(b, h) + aoff + m * 2048 + k * 1024); } while (0)
#define PG8_LDB(dst, b, h) do { _Pragma("unroll") for (int n = 0; n < 2; ++n) _Pragma("unroll") for (int k = 0; k < 2; ++k) dst[n][k] = *(const PG8_LAS bf16x8*)(lds + PG8_SB(b, h) + boff + n * 2048 + k * 1024); } while (0)
#define PG8_MMA(ai, bj, At, Bt) do { __builtin_amdgcn_s_setprio(1); _Pragma("unroll") for (int m = 0; m < 4; ++m) _Pragma("unroll") for (int n = 0; n < 2; ++n) _Pragma("unroll") for (int k = 0; k < 2; ++k) \
        acc[ai][bj][m][n] = __builtin_amdgcn_mfma_f32_16x16x32_bf16(Bt[n][k], At[m][k], acc[ai][bj][m][n], 0, 0, 0); __builtin_amdgcn_s_setprio(0); } while (0)
#define PG8_WAIT_V(n) asm volatile("s_waitcnt vmcnt(" #n ")" ::: "memory")
#define PG8_WAIT_L(n) asm volatile("s_waitcnt lgkmcnt(" #n ")" ::: "memory")
#define PG8_BAR __builtin_amdgcn_s_barrier()
#define PG8_SCHED __builtin_amdgcn_sched_barrier(0)
    Unit cur, nxt; int ui = 0;
    if (!S.next(0, cur)) return;
    f32x4 acc[2][2][4][2];
#pragma unroll
    for (int a = 0; a < 2; ++a)
#pragma unroll
        for (int b = 0; b < 2; ++b)
#pragma unroll
            for (int m = 0; m < 4; ++m)
#pragma unroll
                for (int n = 0; n < 2; ++n) acc[a][b][m][n] = (f32x4){0.f, 0.f, 0.f, 0.f};
    bf16x8 At[4][2], B0[2][2], B1[2][2];
    const char* cA = (const char*)g.A + (size_t)cur.pm * tstepA + (size_t)cur.pn * g.a_pn_off * 2 + (size_t)cur.kt0 * kstep; const char* cB = (const char*)g.Bt + (size_t)cur.pn * tstepB + (size_t)cur.kt0 * kstep;
    S.a_ready(cur);
    PG8_STAGE(PG8_SB(0, 0), cB, voffB); PG8_STAGE(PG8_SB(0, 1), cB + hstepB, voffB); PG8_STAGE(PG8_SA(0, 0), cA, voffA); PG8_STAGE(PG8_SA(0, 1), cA + hstepA, voffA);
    if (wr == 1) PG8_BAR;
    PG8_WAIT_V(2); PG8_BAR;
    PG8_STAGE(PG8_SB(1, 0), cB + kstep, voffB); PG8_STAGE(PG8_SA(1, 0), cA + kstep, voffA); PG8_STAGE(PG8_SB(1, 1), cB + hstepB + kstep, voffB);
    PG8_WAIT_V(6); PG8_BAR;
    for (;;) {
        const bool has_next = S.next(ui + 1, nxt);
        const char* nA = has_next ? (const char*)g.A + (size_t)nxt.pm * tstepA + (size_t)nxt.pn * g.a_pn_off * 2 + (size_t)nxt.kt0 * kstep : cA; const char* nB = has_next ? (const char*)g.Bt + (size_t)nxt.pn * tstepB + (size_t)nxt.kt0 * kstep : cB;
        const int unt = cur.nkt;
        for (int t = 0; t < unt; t += 2) {
            const bool last = (t == unt - 2);
            const char* a1 = cA + (size_t)(t + 1) * kstep;
            const char* a2 = last ? nA : cA + (size_t)(t + 2) * kstep; const char* b2 = last ? nB : cB + (size_t)(t + 2) * kstep;
            const char* a3 = a2 + kstep; const char* b3 = b2 + kstep;
            if (last && has_next) S.a_ready(nxt);
            PG8_LDB(B0, 0, 0); PG8_LDB(B1, 0, 1); PG8_SCHED; PG8_LDA(At, 0, 0); PG8_STAGE(PG8_SA(1, 1), a1 + hstepA, voffA);
            PG8_WAIT_V(8); PG8_WAIT_L(0); PG8_BAR; PG8_MMA(0, 0, At, B0); PG8_MMA(0, 1, At, B1); PG8_BAR; PG8_SCHED;
            PG8_LDA(At, 0, 1); PG8_STAGE(PG8_SB(0, 0), b2, voffB); PG8_STAGE(PG8_SB(0, 1), b2 + hstepB, voffB); PG8_STAGE(PG8_SA(0, 0), a2, voffA);
            PG8_WAIT_V(8); PG8_WAIT_L(0); PG8_BAR; PG8_MMA(1, 0, At, B0); PG8_MMA(1, 1, At, B1); PG8_BAR; PG8_SCHED;
            PG8_LDB(B0, 1, 0); PG8_LDB(B1, 1, 1); PG8_SCHED; PG8_LDA(At, 1, 0); PG8_STAGE(PG8_SA(0, 1), a2 + hstepA, voffA);
            PG8_WAIT_V(8); PG8_WAIT_L(0); PG8_BAR; PG8_MMA(0, 0, At, B0); PG8_MMA(0, 1, At, B1); PG8_BAR; PG8_SCHED;
            PG8_LDA(At, 1, 1); PG8_STAGE(PG8_SB(1, 0), b3, voffB); PG8_STAGE(PG8_SB(1, 1), b3 + hstepB, voffB); PG8_STAGE(PG8_SA(1, 0), a3, voffA);
            PG8_WAIT_V(8); PG8_WAIT_L(0); PG8_BAR; PG8_MMA(1, 0, At, B0); PG8_MMA(1, 1, At, B1); PG8_BAR; PG8_SCHED;
        }
        if constexpr (ALIGN_EPI) { if (wr == 0) PG8_BAR; }
        bool carry = false;
        if constexpr (Epi::MID) carry = cur.part == 2;
        Unit eu = cur; asm volatile("" : "+s"(eu.pm), "+s"(eu.pn));
        if (carry) { if constexpr (Epi::MID) E.mid(acc, eu, wr, wc, fr, fq); }
        else if constexpr (Epi::FINAL) E.run_final(acc, eu, wr, wc, fr, fq);
        else E.run(AccSrc{acc}, eu, wr, wc, fr, fq);
        S.done(cur);
        if (!has_next) break;
        if (!carry) {
#pragma unroll
        for (int a = 0; a < 2; ++a)
#pragma unroll
            for (int b = 0; b < 2; ++b)
#pragma unroll
                for (int m = 0; m < 4; ++m)
#pragma unroll
                    for (int n = 0; n < 2; ++n) acc[a][b][m][n] = (f32x4){0.f, 0.f, 0.f, 0.f};
        }
        cur = nxt; cA = nA; cB = nB; ++ui;
        if constexpr (ALIGN_EPI) { if (wr == 1) PG8_BAR; }
    }
    PG8_WAIT_V(0);
    if constexpr (!ALIGN_EPI) { if (wr == 0) PG8_BAR; }
    PG8_BAR;
#undef PG8_SA
#undef PG8_SB
#undef PG8_STAGE
#undef PG8_LDA
#undef PG8_LDB
#undef PG8_MMA
#undef PG8_WAIT_V
#undef PG8_WAIT_L
#undef PG8_BAR
#undef PG8_SCHED
}
}

constexpr int NWAVES = 8;
constexpr int PER_PHASE = 11;
constexpr int N_LAUNCHES = MK_N_LAUNCHES;

#define GAS __attribute__((address_space(1)))
#define LAS __attribute__((address_space(3)))
typedef unsigned short bf16;
typedef unsigned v4u __attribute__((ext_vector_type(4)));
typedef unsigned v2u __attribute__((ext_vector_type(2)));
typedef float f32x4 __attribute__((ext_vector_type(4)));
typedef float f32x16 __attribute__((ext_vector_type(16)));
typedef short bf16x8 __attribute__((ext_vector_type(8)));
typedef short s16x4 __attribute__((ext_vector_type(4)));
typedef GAS unsigned gu32;
#define RLX_AGENT __ATOMIC_RELAXED, __HIP_MEMORY_SCOPE_AGENT
#define LDS_WAIT() asm volatile("s_waitcnt lgkmcnt(0)" ::: "memory")
#define VM_WAIT() asm volatile("s_waitcnt vmcnt(0)" ::: "memory")
using pg8::pk2; using pg8::pk4;

constexpr size_t MiB = 1u << 20;
constexpr size_t al(size_t x) { return (x + MiB - 1) / MiB * MiB; }
constexpr size_t WS_CTL = 0, CTL_ZERO_BYTES = 1 * MiB;
constexpr size_t WS_W1C = 1 * MiB;
constexpr size_t WS_W1D = WS_W1C + al((size_t)NCAT * DM * 2);
constexpr size_t WS_WIN = WS_W1D + al((size_t)DM * FF * 2);
constexpr size_t WS_WOUT = WS_WIN + al((size_t)NIN * DM * 2);
constexpr size_t WS_W2C = WS_WOUT + al((size_t)DM * DM * 2);
constexpr size_t WS_W2D = WS_W2C + al((size_t)NCAT * DM * 2);
constexpr size_t WS_WPG = WS_W2D + al((size_t)DM * FF * 2);
constexpr size_t WS_WPP = WS_WPG + al((size_t)DM * DM * 2);
constexpr size_t WS_WPOOL = WS_WPP + al((size_t)DM * PLE * 2);
constexpr size_t WS_HB = WS_WPOOL + al((size_t)PWID * 256 * 2);
constexpr size_t WS_G = WS_HB + al((size_t)M * DM * 2);
constexpr size_t WS_QB = WS_G + al((size_t)M * FF * 2);
constexpr size_t WS_KB = WS_QB + al((size_t)M * SBW * 2);
constexpr size_t WS_VB = WS_KB + al((size_t)M * SBW * 2);
constexpr size_t WS_XP = WS_VB + al((size_t)M * SBW * 2);
constexpr size_t WS_PLB = WS_XP + al((size_t)M * PWID * 2);
constexpr size_t WS_C = WS_PLB + al((size_t)M * PWID * 2);
constexpr size_t WS_PROJ = WS_C + al((size_t)M * DM * 2);
constexpr size_t WS_PB = WS_PROJ + al((size_t)M * DM * 2);
constexpr size_t WS_SLAB = WS_PB + al((size_t)M * PLE * 2);
constexpr size_t WS_END = WS_SLAB + 4 * MiB;
constexpr int CW_BAR = 4096;
constexpr int CW_RANK = 12288;
constexpr int CW_CNT = 8192;
constexpr int CW_SSQ = 16384;
constexpr int SSQ_STRIDE = 8704;
static_assert((CW_SSQ + 7 * SSQ_STRIDE) * 4 <= (int)CTL_ZERO_BYTES && SSQ_STRIDE >= M, "CTL words inside the memset region");

constexpr int RING_OFF = 0, RING_BYTES = 131072;
constexpr int LDSCTL_OFF = RING_BYTES, MISC_OFF = LDSCTL_OFF + 320;
constexpr int LDS_BYTES = 147456;

__device__ __forceinline__ float wave_sum(float v) {
#pragma unroll
    for (int o = 1; o < 64; o <<= 1) v += __shfl_xor(v, o);
    return v;
}

#define XB_TMO      128
#define XB_XCNT(j)  (256  + 64 * (j))
#define XB_XSUB(j)  (1280 + 64 * (j))
#define XB_XGEN(j)  (2304 + 64 * (j))
#define XB_TOP      3328
#define XB_TOPGEN   3392
#define XCD_BAR_WORDS 3456
#define XB_SPIN_CAP (1u << 18)
__device__ __forceinline__ unsigned xb_ld(unsigned* p)              { return __hip_atomic_load(p, __ATOMIC_RELAXED, __HIP_MEMORY_SCOPE_AGENT); }
__device__ __forceinline__ unsigned xb_add(unsigned* p, unsigned v) { return __hip_atomic_fetch_add(p, v, __ATOMIC_RELAXED, __HIP_MEMORY_SCOPE_AGENT); }
__device__ __forceinline__ unsigned xb_xcc_id() { return (unsigned)__builtin_amdgcn_s_getreg((3 << 11) | 20) & 0xFu; }
#define XB_SPIN(cond, bar) do { unsigned _sp = 0; while (cond) { __builtin_amdgcn_s_sleep(1); \
    if ((++_sp & 255u) == 0u) { if (xb_ld(&(bar)[XB_TMO])) break; if (_sp > XB_SPIN_CAP) { atomicAdd(&(bar)[XB_TMO], 1u); break; } } } } while (0)
struct XcdBarrier { unsigned* bar; unsigned x; volatile LAS unsigned* st; };
__device__ __forceinline__ XcdBarrier xcd_barrier_post(unsigned* bar, volatile LAS unsigned* st) {
    XcdBarrier b; b.bar = bar; b.x = xb_xcc_id(); b.st = st;
    if (threadIdx.x == 0) (void)xb_add(&bar[XB_XCNT(b.x)], 1u);
    return b;
}
__device__ __forceinline__ void xcd_barrier_complete(unsigned* bar, unsigned x, unsigned& nloc, unsigned& nx) {
    const unsigned G = gridDim.x * gridDim.y * gridDim.z;
    unsigned sum, cnt, mine, sp = 0u;
    for (;;) {
        sum = 0u; cnt = 0u; mine = 0u;
#pragma unroll
        for (unsigned j = 0; j < 16; ++j) { const unsigned c = xb_ld(&bar[XB_XCNT(j)]); sum += c; cnt += (c > 0u) ? 1u : 0u; mine = (j == x) ? c : mine; }
        if (sum == G) break;
        __builtin_amdgcn_s_sleep(1);
        if ((++sp & 255u) == 0u) { if (xb_ld(&bar[XB_TMO])) break; if (sp > XB_SPIN_CAP) { atomicAdd(&bar[XB_TMO], 1u); break; } }
    }
    nloc = mine > 0u ? mine : 1u; nx = cnt > 0u ? cnt : 1u;
}
__device__ __forceinline__ void xcd_barrier(const XcdBarrier& b) {
    asm volatile("s_waitcnt vmcnt(0)" ::: "memory");
    __syncthreads();
    if (threadIdx.x == 0) {
        unsigned* bar = b.bar;
        __builtin_amdgcn_s_waitcnt(0);
        unsigned nloc = b.st[0], nx = b.st[1];
        if (nloc == 0u) { xcd_barrier_complete(bar, b.x, nloc, nx); b.st[0] = nloc; b.st[1] = nx; }
        const unsigned old = xb_add(&bar[XB_XSUB(b.x)], 1u);
        const unsigned gen = old / nloc;
        if (old + 1u == (gen + 1u) * nloc) {
            __builtin_amdgcn_fence(__ATOMIC_RELEASE, "agent");
            asm volatile("s_waitcnt vmcnt(0)" ::: "memory");
            const unsigned og = xb_add(&bar[XB_TOP], 1u);
            const unsigned tg = og / nx;
            if (og + 1u == (tg + 1u) * nx) xb_add(&bar[XB_TOPGEN], 1u);
            else XB_SPIN(xb_ld(&bar[XB_TOPGEN]) == tg, bar);
            __builtin_amdgcn_fence(__ATOMIC_ACQUIRE, "agent");
            xb_add(&bar[XB_XGEN(b.x)], 1u);
            asm volatile("s_waitcnt vmcnt(0)" ::: "memory");
        } else {
            XB_SPIN(xb_ld(&bar[XB_XGEN(b.x)]) == gen, bar);
            __builtin_amdgcn_fence(__ATOMIC_ACQUIRE, "agent");
            asm volatile("s_waitcnt vmcnt(0)" ::: "memory");
        }
    }
    __syncthreads();
}

struct Frame {
    LAS unsigned char* lds;
    volatile LAS unsigned* MISC;
    unsigned* ctl; unsigned char* ws;
    int tid, lane, wave, vcu, G;
    const float* in[25];
    float* out;
    bf16 *W1C, *W1D, *WIN, *WOUT, *W2C, *W2D, *WPG, *WPP, *WPOOL;
    bf16 *HB, *GB, *QB, *KB, *VB, *PLB, *CB, *PROJ, *PB;
    bf16* XP;
    float *ssq0, *ssq1, *ssqA, *ssqP, *ssq2, *ssq3, *ssq4;
};
enum { I_XP = 0, I_XS, I_CK, I_CV, I_SPOOL, I_PP, I_PS, I_GFFN1, I_W1G, I_W1U, I_W1D, I_GMIX, I_WIN, I_GATT, I_WPOOL, I_PSCALE, I_WOUT, I_GFFN2, I_W2G, I_W2U, I_W2D, I_GPLE, I_WPG, I_WPP, I_GFINAL };

constexpr int TRP = 66;
__device__ __forceinline__ void tr_ld(f32x4 (&v)[16], const float* W, int N, int k0, int n0, int lane) {
    const int r4 = lane >> 4, c4 = lane & 15;
#pragma unroll
    for (int i = 0; i < 16; ++i) v[i] = __builtin_nontemporal_load((const GAS f32x4*)(W + (size_t)(k0 + 4 * i + r4) * N + n0 + 4 * c4));
}
__device__ __forceinline__ void tr_st(const f32x4 (&v)[16], const float* ga, bf16* WT, int Kdst, int k0, int drow0, LAS unsigned short* scr, int lane) {
    const int r4 = lane >> 4, c4 = lane & 15;
#pragma unroll
    for (int i = 0; i < 16; ++i) { f32x4 x = v[i]; if (ga) x = x * ga[k0 + 4 * i + r4];
        const v2u w = pk4(x); LAS unsigned* d = (LAS unsigned*)(scr + (4 * i + r4) * TRP + 4 * c4); d[0] = w.x; d[1] = w.y; }
    LDS_WAIT(); asm volatile("" ::: "memory");
    const int c = lane & 7;
#pragma unroll
    for (int j = 0; j < 8; ++j) { const int n = (lane >> 3) + 8 * j; const LAS unsigned short* p = scr + (8 * c) * TRP + n;
        v4u o; o.x = (unsigned)p[0] | ((unsigned)p[TRP] << 16); o.y = (unsigned)p[2 * TRP] | ((unsigned)p[3 * TRP] << 16); o.z = (unsigned)p[4 * TRP] | ((unsigned)p[5 * TRP] << 16); o.w = (unsigned)p[6 * TRP] | ((unsigned)p[7 * TRP] << 16);
        *(GAS v4u*)(WT + (size_t)(drow0 + n) * Kdst + k0 + 8 * c) = o; }
    LDS_WAIT(); asm volatile("" ::: "memory");
}
__device__ __forceinline__ void tr_item(const float* W, int N, const float* ga, bf16* WT, int Kdst, int k0, int n0, int drow0, LAS unsigned short* scr, int lane) {
    f32x4 v[16]; tr_ld(v, W, N, k0, n0, lane); tr_st(v, ga, WT, Kdst, k0, drow0, scr, lane);
}
__device__ __forceinline__ void tr_plain(const float* W, int K, int N, const float* ga, const float* gb, int ghalf, bf16* WT, int r, LAS unsigned short* scr, int lane) {
    const int nblk = N / 64, kb = r / nblk, nb = r % nblk; const float* gk = (64 * kb < ghalf) ? ga : gb;
    tr_item(W, N, gk, WT, K, 64 * kb, 64 * nb, 64 * nb, scr, lane);
}
__device__ __forceinline__ void tr_cat(const float* W, const float* ga, bf16* WT, int half, int r, LAS unsigned short* scr, int lane) {
    const int nblk = FF / 64, kb = r / nblk, nb = r % nblk, n0 = 64 * nb; tr_item(W, FF, ga, WT, DM, 64 * kb, n0, (n0 >> 7) * 256 + half * 128 + (n0 & 127), scr, lane);
}
__device__ __forceinline__ void p0_prologue(Frame& F) {
    LAS unsigned short* scr = (LAS unsigned short*)(F.lds + RING_OFF + F.wave * 16384);
    const int gw = F.vcu * NWAVES + F.wave, NGW = F.G * NWAVES;
    constexpr int I_CAT = (DM / 64) * (FF / 64), I_DN = (FF / 64) * (DM / 64), I_IN = (DM / 64) * (NIN / 64), I_SQ = (DM / 64) * (DM / 64), I_PPJ = (PLE / 64) * (DM / 64), I_PL = 4 * (256 / 64) * (256 / 64);
    constexpr int NITEMS = 4 * I_CAT + 2 * I_DN + I_IN + 2 * I_SQ + I_PPJ + I_PL;
    constexpr int NLATE = NITEMS - 2 * I_CAT;
    for (int it = gw; it < NLATE; it += NGW) {
        int r = it;
        if (r < I_SQ) { tr_plain(F.in[I_WPG], DM, DM, F.in[I_GPLE], nullptr, 1 << 30, F.WPG, r, scr, F.lane); continue; } r -= I_SQ;
        if (r < I_DN) { tr_plain(F.in[I_W2D], FF, DM, nullptr, nullptr, 0, F.W2D, r, scr, F.lane); continue; } r -= I_DN;
        if (r < I_CAT) { tr_cat(F.in[I_W2U], F.in[I_GFFN2], F.W2C, 1, r, scr, F.lane); continue; } r -= I_CAT;
        if (r < I_CAT) { tr_cat(F.in[I_W2G], F.in[I_GFFN2], F.W2C, 0, r, scr, F.lane); continue; } r -= I_CAT;
        if (r < I_SQ) { tr_plain(F.in[I_WOUT], DM, DM, F.in[I_GATT], F.in[I_PSCALE] - SBW, SBW, F.WOUT, r, scr, F.lane); continue; } r -= I_SQ;
        if (r < I_PL) { const int g = r / 16, rr = r % 16; tr_plain(F.in[I_WPOOL] + (size_t)g * 65536, 256, 256, nullptr, nullptr, 0, F.WPOOL + (size_t)g * 65536, rr, scr, F.lane); continue; } r -= I_PL;
        if (r < I_IN) { tr_plain(F.in[I_WIN], DM, NIN, F.in[I_GMIX], nullptr, 1 << 30, F.WIN, r, scr, F.lane); continue; } r -= I_IN;
        if (r < I_DN) { tr_plain(F.in[I_W1D], FF, DM, nullptr, nullptr, 0, F.W1D, r, scr, F.lane); continue; } r -= I_DN;
        tr_plain(F.in[I_WPP], PLE, DM, nullptr, nullptr, 0, F.WPP, r, scr, F.lane);
    }
    for (int m0 = gw; m0 < M; m0 += 2 * NGW) {
        const int m1 = m0 + NGW; const bool two = m1 < M;
        const float* xr0 = (m0 < MP) ? F.in[I_XP] + (size_t)m0 * DM : F.in[I_XS] + (size_t)(m0 - MP) * DM;
        const float* pr0 = (m0 < MP) ? F.in[I_PP] + (size_t)m0 * PLE : F.in[I_PS] + (size_t)(m0 - MP) * PLE;
        const int mm1 = two ? m1 : m0;
        const float* xr1 = (mm1 < MP) ? F.in[I_XP] + (size_t)mm1 * DM : F.in[I_XS] + (size_t)(mm1 - MP) * DM;
        const float* pr1 = (mm1 < MP) ? F.in[I_PP] + (size_t)mm1 * PLE : F.in[I_PS] + (size_t)(mm1 - MP) * PLE;
        f32x4 v0[8], v1[8]; float s0 = 0.f, s1 = 0.f;
#pragma unroll
        for (int j = 0; j < 8; ++j) { v0[j] = __builtin_nontemporal_load((const GAS f32x4*)xr0 + F.lane + 64 * j); v1[j] = __builtin_nontemporal_load((const GAS f32x4*)xr1 + F.lane + 64 * j); }
        const f32x4 p0 = ((const GAS f32x4*)pr0)[F.lane], p1 = ((const GAS f32x4*)pr1)[F.lane];
#pragma unroll
        for (int j = 0; j < 8; ++j) { s0 += pg8::dot4(v0[j]); s1 += pg8::dot4(v1[j]); }
        s0 = wave_sum(s0); s1 = wave_sum(s1);
        if (F.lane == 0) { F.ssq0[m0] = s0; if (two) F.ssq0[m1] = s1; }
        GAS v2u* o0 = (GAS v2u*)(F.HB + (size_t)m0 * DM) + F.lane; GAS v2u* o1 = (GAS v2u*)(F.HB + (size_t)mm1 * DM) + F.lane;
#pragma unroll
        for (int j = 0; j < 8; ++j) o0[64 * j] = pk4(v0[j]);
        ((GAS v2u*)(F.PB + (size_t)m0 * PLE))[F.lane] = pk4(p0);
        if (two) {
#pragma unroll
            for (int j = 0; j < 8; ++j) o1[64 * j] = pk4(v1[j]);
            ((GAS v2u*)(F.PB + (size_t)m1 * PLE))[F.lane] = pk4(p1); }
    }
    for (int it = gw; it < 2 * I_CAT; it += 2 * NGW) {
        constexpr int nblk = FF / 64;
        const int ia = it, ib = it + NGW; const bool two = ib < 2 * I_CAT;
        const int ha = ia >= I_CAT, ra = ia - ha * I_CAT, ka = ra / nblk, na = 64 * (ra % nblk);
        const int ibb = two ? ib : ia, hb = ibb >= I_CAT, rb = ibb - hb * I_CAT, kb = rb / nblk, nb = 64 * (rb % nblk);
        f32x4 va[16], vb[16];
        tr_ld(va, ha ? F.in[I_W1U] : F.in[I_W1G], FF, 64 * ka, na, F.lane);
        if (two) tr_ld(vb, hb ? F.in[I_W1U] : F.in[I_W1G], FF, 64 * kb, nb, F.lane);
        tr_st(va, F.in[I_GFFN1], F.W1C, DM, 64 * ka, (na >> 7) * 256 + ha * 128 + (na & 127), scr, F.lane);
        if (two) tr_st(vb, F.in[I_GFFN1], F.W1C, DM, 64 * kb, (nb >> 7) * 256 + hb * 128 + (nb & 127), scr, F.lane);
    }
}

__device__ __forceinline__ int crow(int r, int hi) { return (r & 3) + 8 * (r >> 2) + 4 * hi; }
__device__ __forceinline__ bf16x8 cvt8(f32x4 a, f32x4 b) { v4u w; w.x = pk2(a[0], a[1]); w.y = pk2(a[2], a[3]); w.z = pk2(b[0], b[1]); w.w = pk2(b[2], b[3]); return __builtin_bit_cast(bf16x8, w); }
typedef short v4i16_t __attribute__((ext_vector_type(4)));
__device__ __forceinline__ s16x4 vtr(LAS const unsigned char* p) { return __builtin_bit_cast(s16x4, __builtin_amdgcn_ds_read_tr16_b64_v4i16((LAS v4i16_t*)p)); }
constexpr int VPITCH = 272;
constexpr int VIMG_BYTES = 32 * VPITCH;
constexpr float SB_STOP = -135.0f;
constexpr int TA_S = 5;

template <bool SAMPLE>
__device__ __forceinline__ void sb_unit(const Frame& F, int b, int h, int qblk, LAS unsigned char* vl, bool dry = false) {
    const int lane = F.lane, qi = lane & 31, hi = lane >> 5;
    const int qrow = SAMPLE ? MP + b * DECS + qi : b * SEQ + qblk * 32 + qi;
    const bf16* qp = F.QB + (size_t)qrow * SBW + h * HD + hi * 8;
    bf16x8 qreg[8];
    if (!SAMPLE) {
#pragma unroll
        for (int ds = 0; ds < 8; ++ds) qreg[ds] = *(const bf16x8*)(qp + ds * 16); }
    f32x16 o[4];
#pragma unroll
    for (int db = 0; db < 4; ++db)
#pragma unroll
        for (int r = 0; r < 16; ++r) o[db][r] = 0.f;
    float R = 0.f;
    const int nblk = SAMPLE ? (PAST / 32 + 1) : qblk + 1;
    const int tr_base = ((4 * (lane >> 5) + ((lane & 15) >> 2)) * VPITCH) + (16 * ((lane >> 4) & 1) + 4 * (lane & 3)) * 2;
    const int srow0 = SAMPLE ? MP + b * DECS : b * SEQ;
    bf16x8 kf[8];
    if (!SAMPLE) { const bf16* kp = F.KB + (size_t)(srow0 + (nblk - 1) * 32 + qi) * SBW + h * HD + hi * 8;
#pragma unroll
      for (int ds = 0; ds < 8; ++ds) kf[ds] = *(const bf16x8*)(kp + ds * 16); }
    { unsigned tx = 0;
      if (SAMPLE) { unsigned tch[8 * TA_S + 4];
          { const size_t ro = (size_t)(srow0 + (lane & 31)) * SBW + h * HD + (lane >> 5) * 32;
            tch[8 * TA_S] = *(const GAS unsigned*)(F.KB + ro); tch[8 * TA_S + 1] = *(const GAS unsigned*)(F.KB + ro + 64); tch[8 * TA_S + 2] = *(const GAS unsigned*)(F.VB + ro); tch[8 * TA_S + 3] = *(const GAS unsigned*)(F.VB + ro + 64); }
#pragma unroll
          for (int i = 0; i < TA_S; ++i) { const size_t ro = (size_t)(b * PAST + (PAST / 32 - 1 - i) * 32 + (lane & 31)) * SBW + h * HD + (lane >> 5) * 16;
#pragma unroll
              for (int t = 0; t < 4; ++t) { tch[8 * i + t] = *(const GAS unsigned*)(F.in[I_CK] + ro + t * 32); tch[8 * i + 4 + t] = *(const GAS unsigned*)(F.in[I_CV] + ro + t * 32); } }
#pragma unroll
          for (int i = 0; i < 8 * TA_S + 4; ++i) tx ^= tch[i];
      }
      asm volatile("" :: "v"(tx)); }
    const unsigned vby_f32 = (unsigned)((lane >> 5) * SBW + (lane & 31) * 4) * 4u;
    const unsigned vby_b16 = (unsigned)((lane >> 4) * SBW + (lane & 15) * 8) * 2u;
    LAS unsigned char* const vl_f32 = vl + (lane >> 5) * VPITCH + (lane & 31) * 8;
    LAS unsigned char* const vl_b16 = vl + (lane >> 4) * VPITCH + (lane & 15) * 16;
    v4u vr[8];
    if (!SAMPLE) {
        const bf16* vp = F.VB + (size_t)(srow0 + (nblk - 1) * 32) * SBW + h * HD;
#pragma unroll
        for (int i = 0; i < 8; ++i) { const char* pb = (const char*)vp + (size_t)i * 4 * SBW * 2; asm volatile("" : "+s"(pb)); vr[i] = *(const GAS v4u*)(pb + vby_b16); } }
    for (int j = nblk - 1; j >= 0; --j) {
        const bool diag = (j == nblk - 1);
        const bool from_cache = SAMPLE && !diag;
        f32x16 st;
#pragma unroll
        for (int r = 0; r < 16; ++r) st[r] = 0.f;
        if (!from_cache) {
            if (SAMPLE) { const bf16* vp = F.VB + (size_t)srow0 * SBW + h * HD;
#pragma unroll
            for (int i = 0; i < 8; ++i) { const char* pb = (const char*)vp + (size_t)i * 4 * SBW * 2; asm volatile("" : "+s"(pb)); vr[i] = *(const GAS v4u*)(pb + vby_b16); } }
            if (SAMPLE) { const bf16* kp = F.KB + (size_t)(srow0 + qi) * SBW + h * HD + hi * 8;
#pragma unroll
                for (int ds = 0; ds < 8; ++ds) kf[ds] = *(const bf16x8*)(kp + ds * 16); }
#pragma unroll
            for (int ds = 0; ds < 8; ++ds) { bf16x8 qf; if (SAMPLE) qf = *(const bf16x8*)(qp + ds * 16); else qf = qreg[ds]; st = __builtin_amdgcn_mfma_f32_32x32x16_bf16(kf[ds], qf, st, 0, 0, 0); }
            if (!SAMPLE && j > 0) {
                const bf16* kp = F.KB + (size_t)(srow0 + (j - 1) * 32 + qi) * SBW + h * HD + hi * 8;
#pragma unroll
                for (int ds = 0; ds < 8; ++ds) kf[ds] = *(const bf16x8*)(kp + ds * 16); }
        } else {
            const float* kp = F.in[I_CK] + ((size_t)(b * PAST + j * 32 + qi) * SBW + h * HD + hi * 8);
            const float* vp = F.in[I_CV] + ((size_t)(b * PAST + j * 32) * SBW + h * HD);
#pragma unroll
            for (int hf = 0; hf < 2; ++hf) { f32x4 ka[4], kb[4];
#pragma unroll
              for (int d4 = 0; d4 < 4; ++d4) { ka[d4] = *(const f32x4*)(kp + (hf * 4 + d4) * 16); kb[d4] = *(const f32x4*)(kp + (hf * 4 + d4) * 16 + 4); }
#pragma unroll
              for (int d4 = 0; d4 < 4; ++d4) { const bf16x8 qf = *(const bf16x8*)(qp + (hf * 4 + d4) * 16); st = __builtin_amdgcn_mfma_f32_32x32x16_bf16(cvt8(ka[d4], kb[d4]), qf, st, 0, 0, 0); }
              asm volatile("" ::: "memory"); }
            { f32x4 vf[16];
#pragma unroll
              for (int i = 0; i < 16; ++i) { const char* pb = (const char*)vp + (size_t)i * 2 * SBW * 4; asm volatile("" : "+s"(pb)); vf[i] = *(const GAS f32x4*)(pb + vby_f32); }
#pragma unroll
              for (int i = 0; i < 16; ++i) *(LAS v2u*)(vl_f32 + i * 2 * VPITCH) = pk4(vf[i]); }
            asm volatile("" ::: "memory");
        }
        float bt[16], om[16];
#pragma unroll
        for (int r = 0; r < 16; ++r) { const float z = fmaxf(st[r], -125.0f);
            const float t = __builtin_amdgcn_exp2f(-z); float b_ = __builtin_amdgcn_rcpf(1.0f + t); float o_ = t * b_;
            if (diag && !(crow(r, hi) < qi)) { b_ = 0.f; o_ = 1.f; }
            bt[r] = b_; om[r] = o_; }
        float e[16], gs[4], pg[4];
#pragma unroll
        for (int g = 0; g < 4; ++g) { e[4 * g + 3] = 1.f; e[4 * g + 2] = om[4 * g + 3]; e[4 * g + 1] = e[4 * g + 2] * om[4 * g + 2]; e[4 * g] = e[4 * g + 1] * om[4 * g + 1]; gs[g] = e[4 * g] * om[4 * g]; }
#pragma unroll
        for (int g = 0; g < 4; ++g) pg[g] = __shfl_xor(gs[g], 32);
        const float scale = __builtin_amdgcn_exp2f(R);
        float after = 1.f; float a[16];
#pragma unroll
        for (int g = 3; g >= 0; --g) { const float tail = scale * after * (hi == 0 ? pg[g] : 1.f);
#pragma unroll
            for (int i = 0; i < 4; ++i) { const int r = 4 * g + i; a[r] = bt[r] * e[r] * tail; }
            after *= gs[g] * pg[g]; }
        R += __builtin_amdgcn_logf(after);
        bf16x8 xf[2];
#pragma unroll
        for (int s = 0; s < 2; ++s) { v4u w; w.x = pk2(a[8 * s + 0], a[8 * s + 1]); w.y = pk2(a[8 * s + 2], a[8 * s + 3]); w.z = pk2(a[8 * s + 4], a[8 * s + 5]); w.w = pk2(a[8 * s + 6], a[8 * s + 7]); xf[s] = __builtin_bit_cast(bf16x8, w); }
        asm volatile("" ::: "memory");
        if (!from_cache) {
#pragma unroll
            for (int i = 0; i < 8; ++i) *(LAS v4u*)(vl_b16 + i * 4 * VPITCH) = vr[i];
            if (!SAMPLE && j > 0) {
                const bf16* vp = F.VB + (size_t)(srow0 + (j - 1) * 32) * SBW + h * HD;
#pragma unroll
                for (int i = 0; i < 8; ++i) { const char* pb = (const char*)vp + (size_t)i * 4 * SBW * 2; asm volatile("" : "+s"(pb)); vr[i] = *(const GAS v4u*)(pb + vby_b16); } }
        }
        LDS_WAIT();
#pragma unroll
        for (int db = 0; db < 4; ++db)
#pragma unroll
            for (int s = 0; s < 2; ++s) { const LAS unsigned char* p = vl + tr_base + (16 * s) * VPITCH + db * 64;
                const s16x4 lo = vtr(p), hi4 = vtr(p + 8 * VPITCH);
                const bf16x8 va = (bf16x8){lo[0], lo[1], lo[2], lo[3], hi4[0], hi4[1], hi4[2], hi4[3]};
                o[db] = __builtin_amdgcn_mfma_f32_32x32x16_bf16(va, xf[s], o[db], 0, 0, 0); }
        LDS_WAIT(); asm volatile("" ::: "memory");
        if (__all(R < SB_STOP)) break;
    }
    float s = 0.f;
#pragma unroll
    for (int db = 0; db < 4; ++db)
#pragma unroll
        for (int r = 0; r < 16; ++r) s += o[db][r] * o[db][r];
    s += __shfl_xor(s, 32);
    if (hi == 0 && !dry) atomicAdd(F.ssqA + qrow, s);
    bf16* cp = F.CB + (size_t)qrow * DM + h * HD + 4 * hi;
#pragma unroll
    for (int db = 0; db < 4; ++db)
#pragma unroll
        for (int g = 0; g < 4; ++g) { v2u w; w.x = pk2(o[db][4 * g], o[db][4 * g + 1]); w.y = pk2(o[db][4 * g + 2], o[db][4 * g + 3]); *(v2u*)(cp + 32 * db + 8 * g) = w; }
}

__device__ __forceinline__ f32x4 ld_bf4(const bf16* p) { const v2u w = *(const v2u*)p; return (f32x4){pg8::bf_lo(w.x), pg8::bf_hi(w.x), pg8::bf_lo(w.y), pg8::bf_hi(w.y)}; }
template <int W>
__device__ __forceinline__ void pool_chunk(const bf16* xsrc, const float* past, int t0, int L, int pos0, bf16* dst, int g, int lane) {
    const int c = g * 256 + lane * 4;
    f32x4 hist[16];
#pragma unroll
    for (int j = 0; j < 16; ++j) { const int t = t0 - 16 + j; f32x4 v = (f32x4){0.f, 0.f, 0.f, 0.f};
        if (t >= 0) v = ld_bf4(xsrc + (size_t)t * PWID + c); else if (past && t >= -PSTATE) v = *(const f32x4*)(past + (size_t)(PSTATE + t) * PWID + c);
        hist[j] = v; }
    f32x4 S = (f32x4){0.f, 0.f, 0.f, 0.f};
#pragma unroll
    for (int i = 1; i <= W; ++i) S += hist[16 - i];
    for (int tb = t0; tb < t0 + L; tb += 16) {
        v2u xraw[16];
#pragma unroll
        for (int j = 0; j < 16; ++j) xraw[j] = *(const v2u*)(xsrc + (size_t)(tb + j) * PWID + c);
#pragma unroll
        for (int j = 0; j < 16; ++j) { const int t = tb + j; const f32x4 xn = (f32x4){pg8::bf_lo(xraw[j].x), pg8::bf_hi(xraw[j].x), pg8::bf_lo(xraw[j].y), pg8::bf_hi(xraw[j].y)};
            S += xn - hist[(j - W) & 15]; hist[j] = xn;
            const int pc = pos0 + t + 1; const float cnt = (float)(pc < W ? pc : W);
            const float icnt = 1.0f / cnt; const f32x4 pooled = S * icnt - xn;
            *(v2u*)(dst + (size_t)t * PWID + c) = pk4(pooled); }
    }
}
__device__ __forceinline__ void pool_unit(const Frame& F, int id) {
    const bf16* xsrc; const float* past = nullptr; bf16* dst; int t0, L, pos0, g;
    if (id < 512) { const int b = id >> 7; g = (id >> 5) & 3; const int ch = id & 31; xsrc = F.XP + (size_t)b * SEQ * PWID; dst = F.PLB + (size_t)b * SEQ * PWID; t0 = ch * 64; L = 64; pos0 = 0; }
    else { const int k = id - 512, b = k >> 2; g = k & 3; xsrc = F.XP + (size_t)(MP + b * DECS) * PWID; dst = F.PLB + (size_t)(MP + b * DECS) * PWID; past = F.in[I_SPOOL] + (size_t)b * PSTATE * PWID; t0 = 0; L = DECS; pos0 = PAST; }
    if (g == 0) pool_chunk<2>(xsrc, past, t0, L, pos0, dst, g, F.lane);
    else if (g == 1) pool_chunk<4>(xsrc, past, t0, L, pos0, dst, g, F.lane);
    else if (g == 2) pool_chunk<8>(xsrc, past, t0, L, pos0, dst, g, F.lane);
    else pool_chunk<16>(xsrc, past, t0, L, pos0, dst, g, F.lane);
}

__device__ __forceinline__ void publish_count(unsigned* cnt) {
    VM_WAIT(); __syncthreads();
    if (threadIdx.x == 0) { __builtin_amdgcn_fence(__ATOMIC_RELEASE, "agent"); VM_WAIT(); (void)__hip_atomic_fetch_add(cnt, 1u, __ATOMIC_RELAXED, __HIP_MEMORY_SCOPE_AGENT); }
}
__device__ __forceinline__ void wait_count(unsigned* cnt, unsigned need, unsigned* tmo) {
    if (threadIdx.x == 0) { unsigned sp = 0;
        while (__hip_atomic_load(cnt, __ATOMIC_RELAXED, __HIP_MEMORY_SCOPE_AGENT) < need) { __builtin_amdgcn_s_sleep(8); if (++sp > (1u << 22)) { atomicAdd(tmo, 1u); break; } }
        __builtin_amdgcn_fence(__ATOMIC_ACQUIRE, "agent"); VM_WAIT(); }
    __syncthreads();
}

__device__ __forceinline__ void xcd_local_barrier(unsigned* cntx, unsigned nloc, unsigned* tmo) {
    VM_WAIT(); __syncthreads();
    if (threadIdx.x == 0) {
        const unsigned old = __hip_atomic_fetch_add(cntx, 1u, __ATOMIC_RELAXED, __HIP_MEMORY_SCOPE_AGENT); const unsigned want = (old / nloc + 1u) * nloc; unsigned sp = 0;
        while (__hip_atomic_load(cntx, __ATOMIC_RELAXED, __HIP_MEMORY_SCOPE_AGENT) < want) { __builtin_amdgcn_s_sleep(1); if (++sp > (1u << 21)) { atomicAdd(tmo, 1u); break; } }
        __builtin_amdgcn_fence(__ATOMIC_ACQUIRE, "agent"); VM_WAIT(); }
    __syncthreads();
}

struct EpiPleFinal {
    static constexpr bool AFTER_DRAIN = false, MID = false, FINAL = true;
    float* y; const pg8::bf16_t* hb; const pg8::bf16_t* proj; const float* ssq; float inv_w; float* ssq4; const float* gfin;
    int mode; unsigned* cnt; unsigned need; unsigned* tmo; XcdBarrier bar;
    template <class Src> __device__ __forceinline__ void run(const Src&, const pg8::Unit&, int, int, int, int) const {}
    __device__ __forceinline__ void run_final(pg8::f32x4 (&acc)[2][2][4][2], const pg8::Unit& u, int wr, int wc, int fr, int fq) const {
        using namespace pg8;
        const int row0 = u.pm * BM + wr * 64 + fr, col0 = u.pn * BM + wc * 32 + 4 * fq;
        { float rsv[2][4]; row_scales(ssq, inv_w, row0, rsv);
#pragma unroll
          for (int ai = 0; ai < 2; ++ai) {
            u32x2 hw[4][2][2], pj[4][2][2];
#pragma unroll
            for (int m = 0; m < 4; ++m)
#pragma unroll
                for (int bj = 0; bj < 2; ++bj)
#pragma unroll
                    for (int n = 0; n < 2; ++n) { const size_t o = (size_t)(row0 + ai * HALF + m * 16) * DM + col0 + bj * HALF + n * 16; hw[m][bj][n] = *(const u32x2*)(hb + o); pj[m][bj][n] = *(const u32x2*)(proj + o); }
#pragma unroll
            for (int m = 0; m < 4; ++m) { const int row = row0 + ai * HALF + m * 16; const float r = rsv[ai][m]; float s = 0.f;
#pragma unroll
                for (int bj = 0; bj < 2; ++bj)
#pragma unroll
                    for (int n = 0; n < 2; ++n) { const u32x2 w = hw[m][bj][n], p = pj[m][bj][n]; const f32x4 b = (f32x4){bf_lo(w.x), bf_hi(w.x), bf_lo(w.y), bf_hi(w.y)};
                        const f32x4 g = acc[ai][bj][m][n] * r; f32x4 v;
                        v[0] = b[0] + sigmoidf_(g[0]) * bf_lo(p.x); v[1] = b[1] + sigmoidf_(g[1]) * bf_hi(p.x); v[2] = b[2] + sigmoidf_(g[2]) * bf_lo(p.y); v[3] = b[3] + sigmoidf_(g[3]) * bf_hi(p.y);
                        acc[ai][bj][m][n] = v; s += dot4(v); }
                s += __shfl_xor(s, 16); s += __shfl_xor(s, 32); if (fq == 0) atomicAdd(ssq4 + row, s); }
          } }
        if (mode == 0) xcd_local_barrier(cnt, 32u, tmo);
        else if (mode == 1) xcd_barrier(bar);
        else { publish_count(cnt); wait_count(cnt, need, tmo); }
        float r4[2][4]; row_scales(ssq4, inv_w, row0, r4);
        f32x4 gv[2][2];
#pragma unroll
        for (int bj = 0; bj < 2; ++bj)
#pragma unroll
            for (int n = 0; n < 2; ++n) gv[bj][n] = *(const f32x4*)(gfin + col0 + bj * HALF + n * 16);
#pragma unroll
        for (int ai = 0; ai < 2; ++ai)
#pragma unroll
            for (int m = 0; m < 4; ++m) { float* yr = y + (size_t)(row0 + ai * HALF + m * 16) * DM + col0; const float r = r4[ai][m];
#pragma unroll
                for (int bj = 0; bj < 2; ++bj)
#pragma unroll
                    for (int n = 0; n < 2; ++n) __builtin_nontemporal_store(acc[ai][bj][m][n] * r * gv[bj][n], (f32x4*)(yr + bj * HALF + n * 16)); }
    }
};

struct Args { const float* in[25]; float* out; unsigned char* ws; int ph_lo, ph_hi; };
__global__ void __launch_bounds__(NWAVES * 64, 2) hymba_fwd(Args args) {
    extern __shared__ __attribute__((aligned(16))) unsigned char lds[];
    Frame F;
    F.lds = (LAS unsigned char*)lds;
    F.MISC = (volatile LAS unsigned*)(F.lds + MISC_OFF);
    F.tid = threadIdx.x; F.lane = F.tid & 63; F.wave = __builtin_amdgcn_readfirstlane(F.tid >> 6);
    F.G = gridDim.x; { const int bx = blockIdx.x; F.vcu = (F.G % 8 == 0) ? (bx % 8) * (F.G / 8) + bx / 8 : bx; }
    unsigned char* ws = args.ws;
    F.ctl = (unsigned*)(ws + WS_CTL); F.ws = ws;
#pragma unroll
    for (int i = 0; i < 25; ++i) F.in[i] = args.in[i];
    F.out = args.out;
    F.W1C = (bf16*)(ws + WS_W1C); F.W1D = (bf16*)(ws + WS_W1D); F.WIN = (bf16*)(ws + WS_WIN); F.WOUT = (bf16*)(ws + WS_WOUT); F.W2C = (bf16*)(ws + WS_W2C); F.W2D = (bf16*)(ws + WS_W2D);
    F.WPG = (bf16*)(ws + WS_WPG); F.WPP = (bf16*)(ws + WS_WPP); F.WPOOL = (bf16*)(ws + WS_WPOOL);
    F.HB = (bf16*)(ws + WS_HB); F.GB = (bf16*)(ws + WS_G); F.QB = (bf16*)(ws + WS_QB); F.KB = (bf16*)(ws + WS_KB); F.VB = (bf16*)(ws + WS_VB); F.PLB = (bf16*)(ws + WS_PLB);
    F.CB = (bf16*)(ws + WS_C); F.PROJ = (bf16*)(ws + WS_PROJ); F.PB = (bf16*)(ws + WS_PB); F.XP = (bf16*)(ws + WS_XP);
    { float* sq = (float*)(F.ctl + CW_SSQ); F.ssq0 = sq; F.ssq1 = sq + SSQ_STRIDE; F.ssqA = sq + 2 * SSQ_STRIDE; F.ssqP = sq + 3 * SSQ_STRIDE; F.ssq2 = sq + 4 * SSQ_STRIDE; F.ssq3 = sq + 5 * SSQ_STRIDE; F.ssq4 = sq + 6 * SSQ_STRIDE; }
    for (int u = F.tid; u < (LDS_BYTES - LDSCTL_OFF) / 4; u += NWAVES * 64) ((LAS unsigned*)(F.lds + LDSCTL_OFF))[u] = 0u;
    __syncthreads();
    const unsigned xcc = xb_xcc_id();
    if (F.tid == 0) F.MISC[20] = __hip_atomic_fetch_add(F.ctl + CW_RANK + 64 * xcc, 1u, __ATOMIC_RELAXED, __HIP_MEMORY_SCOPE_AGENT);
    XcdBarrier bar; bar.bar = (unsigned*)(F.ctl + CW_BAR); bar.x = 0; bar.st = nullptr;
    if (N_LAUNCHES != PER_PHASE) bar = xcd_barrier_post((unsigned*)(F.ctl + CW_BAR), F.MISC + 8);
#define GRID_BAR() do { if (N_LAUNCHES != PER_PHASE) xcd_barrier(bar); } while (0)
    const int lo = args.ph_lo, hi = args.ph_hi;
#define IN(k) (lo <= (k) && (k) < hi)
#define BOTH(k) (IN(k) && IN((k) + 1))
    float* const H = F.out + OFF_Y;
    const float inv_d = 1.0f / DM, inv_s = 1.0f / SBW;
    const int gw = F.vcu * NWAVES + F.wave, NGW = F.G * NWAVES;

    if (IN(0)) { p0_prologue(F); if (BOTH(0)) GRID_BAR(); }
    bool local_ok = false; int cdyn = (int)blockIdx.x;
    if (N_LAUNCHES != PER_PHASE && !FORCE_GRID_SEAMS) {
        if (F.tid == 0) { unsigned good = (F.G == 256) ? 1u : 0u;
#pragma unroll
            for (int q = 0; q < 16; ++q) { const unsigned c_ = __hip_atomic_load(F.ctl + CW_RANK + 64 * q, __ATOMIC_RELAXED, __HIP_MEMORY_SCOPE_AGENT); if (c_ != (q < 8 ? 32u : 0u)) good = 0u; }
            F.MISC[21] = good; }
        __syncthreads();
        local_ok = F.MISC[21] != 0u;
        if (local_ok) cdyn = (int)F.MISC[20] * 8 + (int)xcc;
    }
    unsigned* const lcnt = F.ctl + CW_RANK + 1024 + 64 * (local_ok ? xcc : 0u);
#define SEAM() do { if (N_LAUNCHES != PER_PHASE) { if (local_ok) xcd_local_barrier(lcnt, 32u, F.ctl + CW_CNT + 512); else xcd_barrier(bar); } } while (0)

    const int xg = cdyn % 8, jg = cdyn / 8;
    const int n1 = (xg < 4) ? 4 : 3;
    const bool s1_on = jg < n1 + 2; const int s1_pn = (xg < 4) ? xg * 6 + jg : 24 + (xg - 4) * 5 + jg;
    unsigned* const cnt = F.ctl + CW_CNT;
    unsigned* const tmo = F.ctl + CW_CNT + 512;
#define GEMM_CALL(EPI, SCHED, g, S, E) pg8::gemm_phase<EPI, SCHED>(F.lds + RING_OFF, g, S, E)
#define PG8_COMMA(a, b) pg8::EpiRes<a, b>
    int one = 1, two = 2, zero = 0; asm volatile("" : "+s"(one), "+s"(two), "+s"(zero));

    if (IN(1)) {
        const pg8::Gemm g1{F.HB, F.W1C, M, NCAT, DM, DM, DM, 0}; const pg8::EpiSwiGLU E1{F.GB, F.ssq0, inv_d};
        pg8::SkewOrder K1; K1.init(MP, NCAT, DM, F.G, cdyn, 0, 4); K1.lo[0] = 2 + n1; K1.lo[1] = 1; K1.lo[2] = 1; K1.lo[3] = 1; K1.lo[4] = 2; K1.lo[5] = 0;
        { pg8::OneTile S{32, s1_pn, DM / 64, s1_on ? one : zero}; GEMM_CALL(pg8::EpiSwiGLU, pg8::OneTile, g1, S, E1); if (s1_on) publish_count(cnt + 0); }
        GEMM_CALL(pg8::EpiSwiGLU, pg8::SkewOrder, g1, K1, E1);
        if (jg == 0) { wait_count(cnt + 0, 44u, tmo);
            pg8::Gemm g{F.GB, F.W1D, M, DM, FF, FF, FF, 0}; pg8::OneTile S{32, xg, FF / 64, one};
            pg8::EpiRes<false, true> E{nullptr, nullptr, F.HB, F.HB, F.ssq1, nullptr, 0.f, 0.5f, nullptr, nullptr, 0.f, nullptr, nullptr, nullptr};
            GEMM_CALL(PG8_COMMA(false, true), pg8::OneTile, g, S, E); publish_count(cnt + 64); }
        if (jg < 2) { wait_count(cnt + 64, 8u, tmo);
            pg8::Gemm g{F.HB, F.WIN, M, NIN, DM, DM, DM, 0}; pg8::OneTile S{32, jg * 8 + xg, DM / 64, one};
            pg8::EpiIn E{F.ssq1, inv_d, F.QB, F.KB, F.VB, F.XP, F.out}; GEMM_CALL(pg8::EpiIn, pg8::OneTile, g, S, E); }
        K1.r0 = 4; K1.r1 = 6; GEMM_CALL(pg8::EpiSwiGLU, pg8::SkewOrder, g1, K1, E1);
        { pg8::Gemm g{F.PB, F.WPP, M, DM, PLE, PLE, PLE, 0}; pg8::OneTile S{32, xg, PLE / 64, jg == 31 ? one : zero};
          pg8::EpiBf E{F.PROJ, DM, 0, nullptr}; GEMM_CALL(pg8::EpiBf, pg8::OneTile, g, S, E); }
        if (BOTH(1)) SEAM();
    }
    if (IN(2)) {
        pg8::Gemm g{F.GB, F.W1D, M, DM, FF, FF, FF, 0}; pg8::StaticOrder S; S.init(MP, DM, FF, F.G, cdyn);
        pg8::EpiRes<false, true> E{nullptr, nullptr, F.HB, F.HB, F.ssq1, nullptr, 0.f, 0.5f, nullptr, nullptr, 0.f, nullptr, nullptr, nullptr};
        GEMM_CALL(PG8_COMMA(false, true), pg8::StaticOrder, g, S, E);
        if (BOTH(2)) SEAM();
    }
    if (IN(3)) {
        pg8::Gemm g{F.HB, F.WIN, M, NIN, DM, DM, DM, 0}; pg8::StaticOrder S; S.init(MP, NIN, DM, F.G, cdyn);
        pg8::EpiIn E{F.ssq1, inv_d, F.QB, F.KB, F.VB, F.XP, F.out}; GEMM_CALL(pg8::EpiIn, pg8::StaticOrder, g, S, E);
        if (BOTH(3)) GRID_BAR();
    }
    if (IN(4)) {
        LAS unsigned char* vl = F.lds + RING_OFF + F.wave * VIMG_BYTES;
        constexpr int NU_S = DECB * NH, NU_P = BATCH * NH * (SEQ / 32);
        { const bool is_s = (F.wave == 0 && F.vcu < NU_S);
          const int nsb = (F.vcu < NU_S ? F.vcu : NU_S) + ((F.wave > 0 && F.vcu < NU_S) ? 1 : 0);
          const int idx = gw - nsb;
          if (is_s) sb_unit<true>(F, F.vcu / NH, F.vcu % NH, 0, vl);
          else {
              { const int k = idx, qblk = (SEQ / 32 - 1) - k / (BATCH * NH), bh = k % (BATCH * NH); sb_unit<false>(F, bh / NH, bh % NH, qblk, vl); }
              if (F.vcu >= 196 && F.vcu < 204) { const int k = (NGW - NU_S) + (F.vcu - 196) * NWAVES + F.wave, qblk = (SEQ / 32 - 1) - k / (BATCH * NH), bh = k % (BATCH * NH); sb_unit<false>(F, bh / NH, bh % NH, qblk, vl); }
          } }
        const int pb = F.vcu - 64;
        if (pb >= 0 && pb < 132) {
            const bool smp = pb >= 128; const int pm = smp ? 32 : (pb >> 2), g = smp ? pb - 128 : (pb & 3);
            if (smp) pool_unit(F, 512 + F.wave * 4 + g);
            else if (F.wave < 4) pool_unit(F, ((pm >> 3) << 7) | (g << 5) | ((pm & 7) * 4 + F.wave));
            VM_WAIT(); __syncthreads();
            if (F.tid == 0) { __builtin_amdgcn_fence(__ATOMIC_ACQUIRE, "agent"); VM_WAIT(); }
            __syncthreads();
            pg8::Gemm g5{F.PLB, F.WPOOL, M, PWID, 256, PWID, 256, 256}; pg8::EpiBf E5{F.CB, DM, SBW, F.ssqP};
            pg8::OneTile S{pm, g, 256 / 64, one}; GEMM_CALL(pg8::EpiBf, pg8::OneTile, g5, S, E5);
        }
        if (BOTH(4)) GRID_BAR();
    }
    if (IN(6)) {
        pg8::Gemm g{F.CB, F.WOUT, M, DM, DM, DM, DM, 0}; pg8::HalvesOrder S; S.init(MP, DM, DM, F.G, cdyn);
        pg8::EpiRes<true, true> E{nullptr, nullptr, F.HB, F.HB, F.ssq2, F.ssqP, inv_s, 1.0f, F.ssqA, F.ssqP, inv_s, nullptr, nullptr, nullptr};
        GEMM_CALL(PG8_COMMA(true, true), pg8::HalvesOrder, g, S, E);
        if (BOTH(6)) SEAM();
    }
    if (IN(7)) {
        const pg8::Gemm g5{F.HB, F.W2C, M, NCAT, DM, DM, DM, 0}; const pg8::EpiSwiGLU E5{F.GB, F.ssq2, inv_d};
        pg8::SkewOrder K5; K5.init(MP, NCAT, DM, F.G, cdyn, 0, 1); K5.lo[0] = 1; K5.lo[1] = n1 + 2; K5.lo[2] = 1; K5.lo[3] = 1; K5.lo[4] = 1; K5.lo[5] = 1; K5.hi[0] = 31; K5.hi[2] = 31; K5.hi[3] = 31;
        if (jg == 31) { pg8::Gemm g{F.CB, F.WOUT, M, DM, DM, DM, DM, 0}; pg8::OnePiece S{32, xg, 16, 16, one}; pg8::EpiRaw E{(float*)(ws + WS_SLAB + 2 * MiB)};
            GEMM_CALL(pg8::EpiRaw, pg8::OnePiece, g, S, E); publish_count(cnt + 1536 + 64 * xg); }
        if (jg == 0) { pg8::Gemm g{F.CB, F.WOUT, M, DM, DM, DM, DM, 0}; pg8::OnePiece S{32, xg, zero, 16, one};
            pg8::EpiRes<false, true, true, true> E{nullptr, nullptr, F.HB, F.HB, F.ssq2, F.ssqP, inv_s, 1.0f, F.ssqA, F.ssqP, inv_s, (const float*)(ws + WS_SLAB + 2 * MiB), cnt + 1536 + 64 * xg, tmo};
            pg8::gemm_phase<pg8::EpiRes<false, true, true, true>, pg8::OnePiece>(F.lds + RING_OFF, g, S, E); publish_count(cnt + 128); }
        GEMM_CALL(pg8::EpiSwiGLU, pg8::SkewOrder, g5, K5, E5);
        if (s1_on) { wait_count(cnt + 128, 8u, tmo); pg8::OneTile S{32, s1_pn, DM / 64, one}; GEMM_CALL(pg8::EpiSwiGLU, pg8::OneTile, g5, S, E5); publish_count(cnt + 192); }
        K5.r0 = 1; K5.r1 = 2; GEMM_CALL(pg8::EpiSwiGLU, pg8::SkewOrder, g5, K5, E5);
        if (jg == 31) { wait_count(cnt + 192, 44u, tmo);
            pg8::Gemm g{F.GB, F.W2D, M, DM, FF, FF, FF, 0}; pg8::OnePiece S{32, xg, 44, 44, one}; pg8::EpiRaw E{(float*)(ws + WS_SLAB)};
            GEMM_CALL(pg8::EpiRaw, pg8::OnePiece, g, S, E); publish_count(cnt + 1024 + 64 * xg); }
        if (jg == 0) { wait_count(cnt + 192, 44u, tmo);
            pg8::Gemm g{F.GB, F.W2D, M, DM, FF, FF, FF, 0}; pg8::OnePiece S{32, xg, zero, 44, one};
            pg8::EpiRes<false, true, true> E{nullptr, nullptr, F.HB, F.HB, F.ssq3, nullptr, 0.f, 0.5f, nullptr, nullptr, 0.f, (const float*)(ws + WS_SLAB), cnt + 1024 + 64 * xg, tmo};
            pg8::gemm_phase<pg8::EpiRes<false, true, true>, pg8::OnePiece>(F.lds + RING_OFF, g, S, E); publish_count(cnt + 256); }
        if (jg == 0) { wait_count(cnt + 256, 8u, tmo);
            pg8::Gemm g{F.HB, F.WPG, M, DM, DM, DM, DM, 0}; pg8::OneTile S{32, xg, DM / 64, one};
            EpiPleFinal E{H, F.HB, F.PROJ, F.ssq3, inv_d, F.ssq4, F.in[I_GFINAL], 2, cnt + 320, 8u, tmo, bar}; GEMM_CALL(EpiPleFinal, pg8::OneTile, g, S, E); }
        K5.r0 = 2; K5.r1 = 6; GEMM_CALL(pg8::EpiSwiGLU, pg8::SkewOrder, g5, K5, E5);
        if (BOTH(7)) SEAM();
    }
    if (IN(8)) {
        pg8::Gemm g{F.GB, F.W2D, M, DM, FF, FF, FF, 0}; pg8::StaticOrder S; S.init(MP, DM, FF, F.G, cdyn);
        pg8::EpiRes<false, true> E{nullptr, nullptr, F.HB, F.HB, F.ssq3, nullptr, 0.f, 0.5f, nullptr, nullptr, 0.f, nullptr, nullptr, nullptr};
        GEMM_CALL(PG8_COMMA(false, true), pg8::StaticOrder, g, S, E);
        if (BOTH(8)) SEAM();
    }
    if (IN(9)) {
        { pg8::Gemm gp{F.PB, F.WPP, M, DM, PLE, PLE, PLE, 0}; pg8::StaticOrder Sp; Sp.init(MP, DM, PLE, F.G, cdyn);
          pg8::EpiBf Ep{F.PROJ, DM, 0, nullptr}; GEMM_CALL(pg8::EpiBf, pg8::StaticOrder, gp, Sp, Ep); }
        pg8::Gemm g{F.HB, F.WPG, M, DM, DM, DM, DM, 0}; pg8::StaticOrder S; S.init(MP, DM, DM, F.G, cdyn);
        EpiPleFinal E{H, F.HB, F.PROJ, F.ssq3, inv_d, F.ssq4, F.in[I_GFINAL], local_ok ? 0 : 1, lcnt, 32u, tmo, bar}; GEMM_CALL(EpiPleFinal, pg8::StaticOrder, g, S, E);
    }
#undef IN
#undef BOTH
}

extern "C" void kernel_launch(void* const* d_in, const int* in_sizes, int n_in, void* d_out, int out_size, void* d_ws, size_t ws_size, hipStream_t stream) {
    static int grid = 0;
    if (grid == 0) {
        if (n_in != 25 || in_sizes[0] != MP * DM || (size_t)out_size != OUT_TOTAL || ws_size < WS_END) {
            fprintf(stderr, "kernel_launch: shape/workspace mismatch: n_in %d in0 %d out %d (want %zu) ws %zu (want %zu); nothing launched\n", n_in, n_in > 0 ? in_sizes[0] : -1, out_size, (size_t)OUT_TOTAL, ws_size, (size_t)WS_END); grid = -1; return; }
        int dev = 0, cus = 0, per_cu = 0;
        if (hipGetDevice(&dev) != hipSuccess || hipDeviceGetAttribute(&cus, hipDeviceAttributeMultiprocessorCount, dev) != hipSuccess) { fprintf(stderr, "kernel_launch: device query failed\n"); grid = -1; return; }
        if (hipFuncSetAttribute((const void*)hymba_fwd, hipFuncAttributeMaxDynamicSharedMemorySize, LDS_BYTES) != hipSuccess) { fprintf(stderr, "kernel_launch: hipFuncSetAttribute failed\n"); grid = -1; return; }
        if (hipOccupancyMaxActiveBlocksPerMultiprocessor(&per_cu, (const void*)hymba_fwd, NWAVES * 64, LDS_BYTES) != hipSuccess || per_cu < 1) { fprintf(stderr, "kernel_launch: occupancy query reports %d blocks per CU; nothing launched\n", per_cu); (void)hipGetLastError(); grid = -1; return; }
        if (cus != 256) { fprintf(stderr, "kernel_launch: the phase program deals tiles over 8 groups x 32 workgroups; this device has %d CUs; nothing launched\n", cus); grid = -1; return; }
        grid = cus;
    }
    if (grid < 0) return;
    if (hipMemsetAsync((char*)d_ws + WS_CTL, 0, CTL_ZERO_BYTES, stream) != hipSuccess) { fprintf(stderr, "kernel_launch: memset failed\n"); return; }
    Args a{};
    for (int i = 0; i < 25; ++i) a.in[i] = (const float*)d_in[i];
    a.out = (float*)d_out; a.ws = (unsigned char*)d_ws;
    if (N_LAUNCHES == 1) {
        a.ph_lo = 0; a.ph_hi = PER_PHASE;
        void* kargs[] = {&a};
        const hipError_t e = hipLaunchCooperativeKernel((const void*)hymba_fwd, dim3(grid), dim3(NWAVES * 64), kargs, LDS_BYTES, stream);
        if (e != hipSuccess) fprintf(stderr, "kernel_launch: cooperative launch failed: %s (grid %d)\n", hipGetErrorString(e), grid);
    } else {
        for (int li = 0; li < PER_PHASE; ++li) { a.ph_lo = li; a.ph_hi = li + 1;
            hipLaunchKernelGGL(hymba_fwd, dim3(grid), dim3(NWAVES * 64), LDS_BYTES, stream, a);
            const hipError_t le = hipPeekAtLastError(); if (le != hipSuccess) { fprintf(stderr, "kernel_launch: launch %d failed: %s\n", li, hipGetErrorName(le)); break; } }
    }
}
```

```cpp
#include <hip/hip_runtime.h>
#include <cstdio>
#include <cstdint>

#ifndef MK_N_LAUNCHES
#define MK_N_LAUNCHES 1
#endif
#ifndef FORCE_GRID_SEAMS
#define FORCE_GRID_SEAMS 0
#endif

constexpr int DM = 2048, FF = 5632, NCAT = 2 * FF, NIN = 4096, SBW = 1024, PWID = 1024, PLE = 256;
constexpr int BATCH = 4, SEQ = 2048, DECB = 8, DECS = 32, PAST = 2048, NH = 8, HD = 128, PSTATE = 15;
constexpr int MP = BATCH * SEQ, MS = DECB * DECS, M = MP + MS;
constexpr float RMS_EPS = 1e-6f;
constexpr float LOG2E = 1.4426950408889634f;
constexpr float QSCALE = 0.08838834764831845f * LOG2E;
constexpr size_t OFF_Y = 0;
constexpr size_t OFF_KP = (size_t)M * DM;
constexpr size_t OFF_VP = OFF_KP + (size_t)MP * SBW;
constexpr size_t OFF_PP = OFF_VP + (size_t)MP * SBW;
constexpr size_t OFF_KS = OFF_PP + (size_t)BATCH * PSTATE * PWID;
constexpr size_t OFF_VS = OFF_KS + (size_t)MS * SBW;
constexpr size_t OFF_PS = OFF_VS + (size_t)MS * SBW;
constexpr size_t OUT_TOTAL = OFF_PS + (size_t)DECB * PSTATE * PWID;

namespace pg8 {
#define PG8_LAS __attribute__((address_space(3)))
typedef unsigned short bf16_t;
typedef short bf16x8 __attribute__((ext_vector_type(8)));
typedef float f32x4 __attribute__((ext_vector_type(4)));
typedef unsigned u32x4 __attribute__((ext_vector_type(4)));
typedef unsigned u32x2 __attribute__((ext_vector_type(2)));
constexpr int BM = 256, BK = 64, HALF = 128, HTB = HALF * BK * 2, STAGE_BYTES = 8 * HTB, NXCD = 8, WGM = 4;

__host__ __device__ __forceinline__ int lds_byte(int r, int c) { const int st = (r >> 4) * 2 + (c >> 5), rr = r & 15, cc = c & 31, ob = rr * 64 + cc * 2; return st * 1024 + (ob ^ (((ob >> 9) & 1) << 5)); }
__host__ __device__ __forceinline__ void stage_rc(int b, int& R, int& C) { const int st = b / 1024, sb = b % 1024, swz = sb ^ (((sb >> 9) & 1) << 5); R = (st >> 1) * 16 + swz / 64; C = (st & 1) * 32 + (swz % 64) / 2; }

struct Unit { int pm, pn, kt0, nkt, part; };
struct Gemm { const bf16_t* A; const bf16_t* Bt; int M, N, K, lda, ldb, a_pn_off; };

__host__ __device__ __forceinline__ void tile_of(int wgid_in, int nwg, int nM, int nN, int& pm, int& pn) {
    int wgid = wgid_in; { const int q = nwg / NXCD, r = nwg % NXCD, xcd = wgid % NXCD, off = wgid / NXCD; wgid = (xcd < r ? xcd * (q + 1) : r * (q + 1) + (xcd - r) * q) + off; }
    const int nig = WGM * nN, gid = wgid / nig, fm = gid * WGM, gsz = (nM - fm) < WGM ? (nM - fm) : WGM;
    pm = fm + ((wgid % nig) % gsz); pn = (wgid % nig) / gsz;
}
struct StaticOrder {
    int nM, nN, nwg, G, c, NT;
    __host__ __device__ __forceinline__ void init(int M, int N, int K, int G_, int c_) { nM = M / BM; nN = N / BM; nwg = nM * nN; G = G_; c = c_; NT = K / BK; }
    __host__ __device__ __forceinline__ bool next(int i, Unit& u) const {
        const long L = (long)i * G + c; const bool ok = L < nwg; int pm = 0, pn = 0;
        if (ok) tile_of((int)L, nwg, nM, nN, pm, pn);
        u.pm = pm; u.pn = pn; u.kt0 = 0; u.nkt = NT; u.part = 0; return ok;
    }
    __device__ __forceinline__ void a_ready(const Unit&) const {}
    __device__ __forceinline__ void done(const Unit&) const {}
};
struct HalvesOrder {
    int nM, nN, nwg, G, c, NT;
    __host__ __device__ __forceinline__ void init(int M, int N, int K, int G_, int c_) { nM = M / BM; nN = N / BM; nwg = nM * nN; G = G_; c = c_; NT = K / BK; }
    __host__ __device__ __forceinline__ bool next(int i, Unit& u) const {
        const long L = (long)(i >> 1) * G + c; const bool ok = L < nwg; int pm = 0, pn = 0;
        if (ok) tile_of((int)L, nwg, nM, nN, pm, pn);
        const int nkt = NT >> 1;
        u.pm = pm; u.pn = pn; u.kt0 = (i & 1) * nkt; u.nkt = nkt; u.part = (i & 1) ? 0 : 2; return ok;
    }
    __device__ __forceinline__ void a_ready(const Unit&) const {}
    __device__ __forceinline__ void done(const Unit&) const {}
};
template <bool HALVES> struct OneTileT {
    int pm, pn, NT, on;
    __host__ __device__ __forceinline__ bool next(int i, Unit& u) const {
        const int nkt = HALVES ? (NT >> 1) : NT;
        u.pm = pm; u.pn = pn; u.kt0 = HALVES ? (i & 1) * nkt : 0; u.nkt = nkt; u.part = HALVES ? ((i & 1) ? 0 : 2) : 0;
        return on > i * (HALVES ? 1 : 2);
    }
    __device__ __forceinline__ void a_ready(const Unit&) const {}
    __device__ __forceinline__ void done(const Unit&) const {}
};
typedef OneTileT<false> OneTile; typedef OneTileT<true> OneTileH;
struct OnePiece {
    int pm, pn, kt0, nkt, on;
    __host__ __device__ __forceinline__ bool next(int i, Unit& u) const { u.pm = pm; u.pn = pn; u.kt0 = kt0; u.nkt = nkt; u.part = 0; return on > i * 2; }
    __device__ __forceinline__ void a_ready(const Unit&) const {}
    __device__ __forceinline__ void done(const Unit&) const {}
};
struct SkewOrder {
    int nM, nN, nwg, chunk, x, j, r0, r1, NT; int lo[6], hi[6];
    __host__ __device__ __forceinline__ void init(int M, int N, int K, int G, int c, int r0_, int r1_) { nM = M / BM; nN = N / BM; nwg = nM * nN; chunk = nwg / NXCD; x = c % NXCD; j = c / NXCD; r0 = r0_; r1 = r1_; NT = K / BK; (void)G;
#pragma unroll
        for (int r = 0; r < 6; ++r) hi[r] = 32; }
    __host__ __device__ __forceinline__ bool next(int i, Unit& u) const {
        int pre = 0, k = 0, off = -1;
#pragma unroll
        for (int r = 0; r < 6; ++r) { const bool act = j >= lo[r] && j < hi[r]; if (act && r >= r0 && r < r1) { if (k == i) off = pre + (j - lo[r]); ++k; } pre += hi[r] - lo[r]; }
        const bool ok = off >= 0 && off < chunk; int pm = 0, pn = 0;
        if (ok) { const int wgid = x * chunk + off; const int nig = WGM * nN, gid = wgid / nig, fm = gid * WGM, gsz = (nM - fm) < WGM ? (nM - fm) : WGM; pm = fm + ((wgid % nig) % gsz); pn = (wgid % nig) / gsz; }
        u.pm = pm; u.pn = pn; u.kt0 = 0; u.nkt = NT; u.part = 0; return ok;
    }
    __device__ __forceinline__ void a_ready(const Unit&) const {}
    __device__ __forceinline__ void done(const Unit&) const {}
};
typedef float f32x2 __attribute__((ext_vector_type(2)));
typedef __bf16 bf16x2_t __attribute__((ext_vector_type(2)));
__device__ __forceinline__ unsigned pk2(float lo, float hi) { f32x2 v = {lo, hi}; bf16x2_t b = __builtin_convertvector(v, bf16x2_t); return __builtin_bit_cast(unsigned, b); }
__device__ __forceinline__ u32x2 pk4(f32x4 v) { u32x2 w; w.x = pk2(v[0], v[1]); w.y = pk2(v[2], v[3]); return w; }
__device__ __forceinline__ float bf_lo(unsigned w) { return __uint_as_float(w << 16); }
__device__ __forceinline__ float bf_hi(unsigned w) { return __uint_as_float(w & 0xffff0000u); }
__device__ __forceinline__ float rs_of(float ssq, float inv_w) { return __builtin_amdgcn_rsqf(ssq * inv_w + RMS_EPS); }
__device__ __forceinline__ float sigmoidf_(float g) { return __builtin_amdgcn_rcpf(1.0f + __builtin_amdgcn_exp2f(-g * LOG2E)); }
__device__ __forceinline__ float dot4(f32x4 v) { return (v[0] * v[0] + v[1] * v[1]) + (v[2] * v[2] + v[3] * v[3]); }

__device__ __forceinline__ void row_scales(const float* ssq, float inv_w, int row0, float (&rsv)[2][4]) {
    float q[2][4];
#pragma unroll
    for (int ai = 0; ai < 2; ++ai)
#pragma unroll
        for (int m = 0; m < 4; ++m) q[ai][m] = ssq[row0 + ai * HALF + m * 16];
#pragma unroll
    for (int ai = 0; ai < 2; ++ai)
#pragma unroll
        for (int m = 0; m < 4; ++m) rsv[ai][m] = rs_of(q[ai][m], inv_w);
}

struct AccSrc { const f32x4 (&acc)[2][2][4][2]; __device__ __forceinline__ f32x4 operator()(int ai, int bj, int m, int n) const { return acc[ai][bj][m][n]; } };
struct EpiSwiGLU {
    static constexpr bool AFTER_DRAIN = false, MID = false, FINAL = false;
    bf16_t* G; const float* ssq; float inv_w;
    template <class Src> __device__ __forceinline__ void run(const Src& src, const Unit& u, int wr, int wc, int fr, int fq) const {
        const int row0 = u.pm * BM + wr * 64 + fr, col0 = u.pn * HALF + wc * 32 + 4 * fq;
        float rsv[2][4]; row_scales(ssq, inv_w, row0, rsv);
#pragma unroll
        for (int ai = 0; ai < 2; ++ai)
#pragma unroll
            for (int m = 0; m < 4; ++m) { const int row = row0 + ai * HALF + m * 16; const float r = rsv[ai][m]; bf16_t* rowp = G + (size_t)row * FF + col0;
#pragma unroll
                for (int n = 0; n < 2; ++n) { const f32x4 g = src(ai, 0, m, n) * r, up = src(ai, 1, m, n) * r; f32x4 v;
#pragma unroll
                    for (int i = 0; i < 4; ++i) v[i] = g[i] * sigmoidf_(g[i]) * up[i];
                    *(u32x2*)(rowp + n * 16) = pk4(v); }
                if (m & 1) asm volatile("" ::: "memory"); }
    }
};
struct EpiBf {
    static constexpr bool AFTER_DRAIN = false, MID = false, FINAL = false;
    bf16_t* O; int ldc, col_base; float* ssq_out;
    template <class Src> __device__ __forceinline__ void run(const Src& src, const Unit& u, int wr, int wc, int fr, int fq) const {
        const int row0 = u.pm * BM + wr * 64 + fr, col0 = col_base + u.pn * BM + wc * 32 + 4 * fq;
#pragma unroll
        for (int ai = 0; ai < 2; ++ai)
#pragma unroll
            for (int m = 0; m < 4; ++m) { const int row = row0 + ai * HALF + m * 16; bf16_t* rowp = O + (size_t)row * ldc + col0; float s = 0.f;
#pragma unroll
                for (int bj = 0; bj < 2; ++bj)
#pragma unroll
                    for (int n = 0; n < 2; ++n) { const f32x4 v = src(ai, bj, m, n); *(u32x2*)(rowp + bj * HALF + n * 16) = pk4(v); s += dot4(v); }
                if (ssq_out) { s += __shfl_xor(s, 16); s += __shfl_xor(s, 32); if (fq == 0) atomicAdd(ssq_out + row, s); }
                if (m & 1) asm volatile("" ::: "memory"); }
    }
};
struct EpiRaw {
    static constexpr bool AFTER_DRAIN = false, MID = false, FINAL = false;
    float* slab;
    template <class Src> __device__ __forceinline__ void run(const Src& src, const Unit& u, int wr, int wc, int fr, int fq) const {
        float* t = slab + (size_t)u.pn * 65536 + (size_t)(wr * 64 + fr) * 256 + wc * 32 + 4 * fq;
#pragma unroll
        for (int ai = 0; ai < 2; ++ai)
#pragma unroll
            for (int m = 0; m < 4; ++m)
#pragma unroll
                for (int bj = 0; bj < 2; ++bj)
#pragma unroll
                    for (int n = 0; n < 2; ++n) *(f32x4*)(t + (ai * HALF + m * 16) * 256 + bj * HALF + n * 16) = src(ai, bj, m, n);
    }
};
template <bool HAS_MID, bool BASE_BF16, bool ADD_SLAB = false, bool PRE_SCALE = false> struct EpiRes {
    static constexpr bool AFTER_DRAIN = false, MID = HAS_MID, FINAL = false;
    const float* base0; const float* base1;
    const bf16_t* baseb; bf16_t* outb; float* ssq_out;
    const float* ssq_rs; float inv_w_rs, alpha;
    const float* ssq_a; const float* ssq_p; float inv_w_mid;
    const float* slab; unsigned* flag; unsigned* tmo;
    __device__ __forceinline__ float midf(int row) const { return __builtin_amdgcn_sqrtf((ssq_p[row] * inv_w_mid + RMS_EPS) * __builtin_amdgcn_rcpf(ssq_a[row] * inv_w_mid + RMS_EPS)); }
    __device__ __forceinline__ void mid(f32x4 (&acc)[2][2][4][2], const Unit& u, int wr, int wc, int fr, int fq) const {
        const int row0 = u.pm * BM + wr * 64 + fr;
        float qa[2][4], qp[2][4];
#pragma unroll
        for (int ai = 0; ai < 2; ++ai)
#pragma unroll
            for (int m = 0; m < 4; ++m) { const int row = row0 + ai * HALF + m * 16; qa[ai][m] = ssq_a[row]; qp[ai][m] = ssq_p[row]; }
#pragma unroll
        for (int ai = 0; ai < 2; ++ai)
#pragma unroll
            for (int m = 0; m < 4; ++m) { const float f = __builtin_amdgcn_sqrtf((qp[ai][m] * inv_w_mid + RMS_EPS) * __builtin_amdgcn_rcpf(qa[ai][m] * inv_w_mid + RMS_EPS));
#pragma unroll
                for (int bj = 0; bj < 2; ++bj)
#pragma unroll
                    for (int n = 0; n < 2; ++n) acc[ai][bj][m][n] *= f; }
    }
    template <class Src> __device__ __forceinline__ void run(const Src& src, const Unit& u, int wr, int wc, int fr, int fq) const {
        const int row0 = u.pm * BM + wr * 64 + fr, col0 = u.pn * BM + wc * 32 + 4 * fq;
        const float* base = (u.pm * BM < MP) ? base0 : base1;
        const float* pt = nullptr;
        float scv[2][4];
        if (ssq_rs) { row_scales(ssq_rs, inv_w_rs, row0, scv);
#pragma unroll
            for (int ai = 0; ai < 2; ++ai)
#pragma unroll
                for (int m = 0; m < 4; ++m) scv[ai][m] *= alpha; }
        else {
#pragma unroll
            for (int ai = 0; ai < 2; ++ai)
#pragma unroll
                for (int m = 0; m < 4; ++m) scv[ai][m] = alpha; }
        if constexpr (ADD_SLAB) {
            if (threadIdx.x == 0) { unsigned sp = 0;
                while (__hip_atomic_load(flag, __ATOMIC_RELAXED, __HIP_MEMORY_SCOPE_AGENT) == 0u) { __builtin_amdgcn_s_sleep(8); if (++sp > (1u << 22)) { atomicAdd(tmo, 1u); break; } }
                __builtin_amdgcn_fence(__ATOMIC_ACQUIRE, "agent"); asm volatile("s_waitcnt vmcnt(0)" ::: "memory"); }
            asm volatile("" ::: "memory"); __builtin_amdgcn_s_barrier(); asm volatile("" ::: "memory");
            pt = slab + (size_t)u.pn * 65536 + (size_t)(wr * 64 + fr) * 256 + wc * 32 + 4 * fq; }
#pragma unroll
        for (int ai = 0; ai < 2; ++ai) {
            u32x2 bw[4][2][2];
            if constexpr (BASE_BF16) {
#pragma unroll
                for (int m = 0; m < 4; ++m)
#pragma unroll
                    for (int bj = 0; bj < 2; ++bj)
#pragma unroll
                        for (int n = 0; n < 2; ++n) bw[m][bj][n] = *(const u32x2*)(baseb + (size_t)(row0 + ai * HALF + m * 16) * DM + col0 + bj * HALF + n * 16); }
#pragma unroll
            for (int m = 0; m < 4; ++m) { const int row = row0 + ai * HALF + m * 16; const size_t off = (size_t)row * DM + col0;
                const float sc = scv[ai][m]; float s = 0.f; float pre = 1.0f; if constexpr (PRE_SCALE) pre = midf(row);
                f32x4 sl[2][2];
                if constexpr (ADD_SLAB) {
#pragma unroll
                    for (int bj = 0; bj < 2; ++bj)
#pragma unroll
                        for (int n = 0; n < 2; ++n) sl[bj][n] = *(const f32x4*)(pt + (ai * HALF + m * 16) * 256 + bj * HALF + n * 16); }
#pragma unroll
                for (int bj = 0; bj < 2; ++bj)
#pragma unroll
                    for (int n = 0; n < 2; ++n) { const int co = bj * HALF + n * 16; f32x4 b;
                        if constexpr (BASE_BF16) { const u32x2 w = bw[m][bj][n]; b = (f32x4){bf_lo(w.x), bf_hi(w.x), bf_lo(w.y), bf_hi(w.y)}; }
                        else b = *(const f32x4*)(base + off + co);
                        f32x4 a4 = src(ai, bj, m, n); if constexpr (PRE_SCALE) a4 *= pre; if constexpr (ADD_SLAB) a4 += sl[bj][n];
                        const f32x4 v = b + a4 * sc;
                        *(u32x2*)(outb + off + co) = pk4(v); s += dot4(v); }
                s += __shfl_xor(s, 16); s += __shfl_xor(s, 32); if (fq == 0) atomicAdd(ssq_out + row, s);
                if (m & 1) asm volatile("" ::: "memory"); }
        }
    }
};
struct EpiIn {
    static constexpr bool AFTER_DRAIN = false, MID = false, FINAL = false;
    const float* ssq; float inv_w; bf16_t *qb, *kb, *vb, *xp; float* out;
    template <class Src> __device__ __forceinline__ void run(const Src& src, const Unit& u, int wr, int wc, int fr, int fq) const {
        const int row0 = u.pm * BM + wr * 64 + fr, seg = u.pn >> 2, cseg = (u.pn & 3) * BM + wc * 32 + 4 * fq;
        const bool prompt = u.pm * BM < MP;
        float rsv[2][4]; row_scales(ssq, inv_w, row0, rsv);
#pragma unroll
        for (int ai = 0; ai < 2; ++ai)
#pragma unroll
            for (int m = 0; m < 4; ++m) { const int row = row0 + ai * HALF + m * 16; const float r = rsv[ai][m]; const size_t off = (size_t)row * SBW + cseg;
                float* fo = nullptr; float* po = nullptr;
                if (seg == 1) fo = prompt ? out + OFF_KP + off : out + OFF_KS + ((size_t)(row - MP) * SBW + cseg);
                if (seg == 2) fo = prompt ? out + OFF_VP + off : out + OFF_VS + ((size_t)(row - MP) * SBW + cseg);
                if (seg == 3) { if (prompt) { const int b = row / SEQ, t = row % SEQ; if (t >= SEQ - PSTATE) po = out + OFF_PP + ((size_t)(b * PSTATE + t - (SEQ - PSTATE)) * PWID + cseg); }
                                else { const int rs_ = row - MP, b = rs_ / DECS, t = rs_ % DECS; if (t >= DECS - PSTATE) po = out + OFF_PS + ((size_t)(b * PSTATE + t - (DECS - PSTATE)) * PWID + cseg); } }
#pragma unroll
                for (int bj = 0; bj < 2; ++bj)
#pragma unroll
                    for (int n = 0; n < 2; ++n) { const int co = bj * HALF + n * 16; const f32x4 v = src(ai, bj, m, n) * r;
                        if (seg == 0) *(u32x2*)(qb + off + co) = pk4(v * QSCALE);
                        else if (seg == 1) { *(u32x2*)(kb + off + co) = pk4(v); __builtin_nontemporal_store(v, (f32x4*)(fo + co)); }
                        else if (seg == 2) { *(u32x2*)(vb + off + co) = pk4(v); __builtin_nontemporal_store(v, (f32x4*)(fo + co)); }
                        else { *(u32x2*)(xp + off + co) = pk4(v); if (po) *(f32x4*)(po + co) = v; } }
                if (m & 1) asm volatile("" ::: "memory"); }
    }
};
struct EpiPle {
    static constexpr bool AFTER_DRAIN = false, MID = false, FINAL = false;
    bf16_t* h; const bf16_t* hb; const bf16_t* proj; const float* ssq; float inv_w; float* ssq_out;
    template <class Src> __device__ __forceinline__ void run(const Src& src, const Unit& u, int wr, int wc, int fr, int fq) const {
        const int row0 = u.pm * BM + wr * 64 + fr, col0 = u.pn * BM + wc * 32 + 4 * fq;
        float rsv[2][4]; row_scales(ssq, inv_w, row0, rsv);
#pragma unroll
        for (int ai = 0; ai < 2; ++ai) {
            u32x2 hw[4][2][2], pj[4][2][2];
#pragma unroll
            for (int m = 0; m < 4; ++m)
#pragma unroll
                for (int bj = 0; bj < 2; ++bj)
#pragma unroll
                    for (int n = 0; n < 2; ++n) { const size_t o = (size_t)(row0 + ai * HALF + m * 16) * DM + col0 + bj * HALF + n * 16; hw[m][bj][n] = *(const u32x2*)(hb + o); pj[m][bj][n] = *(const u32x2*)(proj + o); }
#pragma unroll
            for (int m = 0; m < 4; ++m) { const int row = row0 + ai * HALF + m * 16; const size_t off = (size_t)row * DM + col0; const float r = rsv[ai][m]; float s = 0.f;
#pragma unroll
                for (int bj = 0; bj < 2; ++bj)
#pragma unroll
                    for (int n = 0; n < 2; ++n) { const int co = bj * HALF + n * 16; const u32x2 w = hw[m][bj][n], p = pj[m][bj][n]; const f32x4 b = (f32x4){bf_lo(w.x), bf_hi(w.x), bf_lo(w.y), bf_hi(w.y)};
                        const f32x4 g = src(ai, bj, m, n) * r; f32x4 v;
                        v[0] = b[0] + sigmoidf_(g[0]) * bf_lo(p.x); v[1] = b[1] + sigmoidf_(g[1]) * bf_hi(p.x); v[2] = b[2] + sigmoidf_(g[2]) * bf_lo(p.y); v[3] = b[3] + sigmoidf_(g[3]) * bf_hi(p.y);
                        *(u32x2*)(h + off + co) = pk4(v); s += dot4(v); }
                s += __shfl_xor(s, 16); s += __shfl_xor(s, 32); if (fq == 0) atomicAdd(ssq_out + row, s);
                if (m & 1) asm volatile("" ::: "memory"); }
        }
    }
};

template <class Epi, class Sched, bool ALIGN_EPI = true>
__device__ __forceinline__ void gemm_phase(PG8_LAS unsigned char* lds, const Gemm g, const Sched& S, const Epi& E) {
    const int tid = threadIdx.x, wid = __builtin_amdgcn_readfirstlane(tid >> 6), lane = tid & 63, wr = wid >> 2, wc = wid & 3, fr = lane & 15, fq = lane >> 4;
    int K_ = g.K; asm volatile("" : "+s"(K_));
    const int K = K_, nt = K / BK;
    unsigned voffA[2], voffB[2];
#pragma unroll
    for (int i = 0; i < 2; ++i) { int R, C; stage_rc(tid * 16 + i * 8192, R, C); voffA[i] = (unsigned)(R * g.lda + C) * 2u; voffB[i] = (unsigned)(R * g.ldb + C) * 2u; }
    const size_t kstep = (size_t)(BK * 2);
    const size_t hstepA = (size_t)HALF * g.lda * 2, hstepB = (size_t)HALF * g.ldb * 2;
    const size_t tstepA = 2 * hstepA, tstepB = 2 * hstepB;
    const unsigned ldsw = (unsigned)wid * 1024u;
    const int aoff = lds_byte(wr * 64 + fr, fq * 8), boff = lds_byte(wc * 32 + fr, fq * 8);
#define PG8_SA(b, h) (((b) * 2 + (h)) * HTB)
#define PG8_SB(b, h) ((4 + (b) * 2 + (h)) * HTB)
#define PG8_STAGE(bufoff, gbase, voff) do { _Pragma("unroll") for (int _i = 0; _i < 2; ++_i) \
        __builtin_amdgcn_global_load_lds((const unsigned*)((const char*)(gbase) + (voff)[_i]), (PG8_LAS unsigned*)(lds + (bufoff) + ldsw + _i * 8192), 16, 0, 0); } while (0)
#define PG8_LDA(dst, b, h) do { _Pragma("unroll") for (int m = 0; m < 4; ++m) _Pragma("unroll") for (int k = 0; k < 2; ++k) dst[m][k] = *(const PG8_LAS bf16x8*)(lds + PG8_SA(b, h) + aoff + m * 2048 + k * 1024); } while (0)
#define PG8_LDB(dst, b, h) do { _Pragma("unroll") for (int n = 0; n < 2; ++n) _Pragma("unroll") for (int k = 0; k < 2; ++k) dst[n][k] = *(const PG8_LAS bf16x8*)(lds + PG8_SB(b, h) + boff + n * 2048 + k * 1024); } while (0)
#define PG8_MMA(ai, bj, At, Bt) do { __builtin_amdgcn_s_setprio(1); _Pragma("unroll") for (int m = 0; m < 4; ++m) _Pragma("unroll") for (int n = 0; n < 2; ++n) _Pragma("unroll") for (int k = 0; k < 2; ++k) \
        acc[ai][bj][m][n] = __builtin_amdgcn_mfma_f32_16x16x32_bf16(Bt[n][k], At[m][k], acc[ai][bj][m][n], 0, 0, 0); __builtin_amdgcn_s_setprio(0); } while (0)
#define PG8_WAIT_V(n) asm volatile("s_waitcnt vmcnt(" #n ")" ::: "memory")
#define PG8_WAIT_L(n) asm volatile("s_waitcnt lgkmcnt(" #n ")" ::: "memory")
#define PG8_BAR __builtin_amdgcn_s_barrier()
#define PG8_SCHED __builtin_amdgcn_sched_barrier(0)
    Unit cur, nxt; int ui = 0;
    if (!S.next(0, cur)) return;
    f32x4 acc[2][2][4][2];
#pragma unroll
    for (int a = 0; a < 2; ++a)
#pragma unroll
        for (int b = 0; b < 2; ++b)
#pragma unroll
            for (int m = 0; m < 4; ++m)
#pragma unroll
                for (int n = 0; n < 2; ++n) acc[a][b][m][n] = (f32x4){0.f, 0.f, 0.f, 0.f};
    bf16x8 At[4][2], B0[2][2], B1[2][2];
    const char* cA = (const char*)g.A + (size_t)cur.pm * tstepA + (size_t)cur.pn * g.a_pn_off * 2 + (size_t)cur.kt0 * kstep; const char* cB = (const char*)g.Bt + (size_t)cur.pn * tstepB + (size_t)cur.kt0 * kstep;
    S.a_ready(cur);
    PG8_STAGE(PG8_SB(0, 0), cB, voffB); PG8_STAGE(PG8_SB(0, 1), cB + hstepB, voffB); PG8_STAGE(PG8_SA(0, 0), cA, voffA); PG8_STAGE(PG8_SA(0, 1), cA + hstepA, voffA);
    if (wr == 1) PG8_BAR;
    PG8_WAIT_V(2); PG8_BAR;
    PG8_STAGE(PG8_SB(1, 0), cB + kstep, voffB); PG8_STAGE(PG8_SA(1, 0), cA + kstep, voffA); PG8_STAGE(PG8_SB(1, 1), cB + hstepB + kstep, voffB);
    PG8_WAIT_V(6); PG8_BAR;
    for (;;) {
        const bool has_next = S.next(ui + 1, nxt);
        const char* nA = has_next ? (const char*)g.A + (size_t)nxt.pm * tstepA + (size_t)nxt.pn * g.a_pn_off * 2 + (size_t)nxt.kt0 * kstep : cA; const char* nB = has_next ? (const char*)g.Bt + (size_t)nxt.pn * tstepB + (size_t)nxt.kt0 * kstep : cB;
        const int unt = cur.nkt;
        asm volatile(".p2align 8" ::: "memory");
        for (int t = 0; t < unt; t += 2) {
            const bool last = (t == unt - 2);
            const char* a1 = cA + (size_t)(t + 1) * kstep;
            const char* a2 = last ? nA : cA + (size_t)(t + 2) * kstep; const char* b2 = last ? nB : cB + (size_t)(t + 2) * kstep;
            const char* a3 = a2 + kstep; const char* b3 = b2 + kstep;
            if (last && has_next) S.a_ready(nxt);
            PG8_LDB(B0, 0, 0); PG8_LDB(B1, 0, 1); PG8_SCHED; PG8_LDA(At, 0, 0); PG8_STAGE(PG8_SA(1, 1), a1 + hstepA, voffA);
            PG8_WAIT_V(8); PG8_WAIT_L(0); PG8_BAR; PG8_MMA(0, 0, At, B0); PG8_MMA(0, 1, At, B1); PG8_BAR; PG8_SCHED;
            PG8_LDA(At, 0, 1); PG8_STAGE(PG8_SB(0, 0), b2, voffB); PG8_STAGE(PG8_SB(0, 1), b2 + hstepB, voffB); PG8_STAGE(PG8_SA(0, 0), a2, voffA);
            PG8_WAIT_V(8); PG8_WAIT_L(0); PG8_BAR; PG8_MMA(1, 0, At, B0); PG8_MMA(1, 1, At, B1); PG8_BAR; PG8_SCHED;
            PG8_LDB(B0, 1, 0); PG8_LDB(B1, 1, 1); PG8_SCHED; PG8_LDA(At, 1, 0); PG8_STAGE(PG8_SA(0, 1), a2 + hstepA, voffA);
            PG8_WAIT_V(8); PG8_WAIT_L(0); PG8_BAR; PG8_MMA(0, 0, At, B0); PG8_MMA(0, 1, At, B1); PG8_BAR; PG8_SCHED;
            PG8_LDA(At, 1, 1); PG8_STAGE(PG8_SB(1, 0), b3, voffB); PG8_STAGE(PG8_SB(1, 1), b3 + hstepB, voffB); PG8_STAGE(PG8_SA(1, 0), a3, voffA);
            PG8_WAIT_V(8); PG8_WAIT_L(0); PG8_BAR; PG8_MMA(1, 0, At, B0); PG8_MMA(1, 1, At, B1); PG8_BAR; PG8_SCHED;
        }
        if constexpr (ALIGN_EPI) { if (wr == 0) PG8_BAR; }
        bool carry = false;
        if constexpr (Epi::MID) carry = cur.part == 2;
        Unit eu = cur; asm volatile("" : "+s"(eu.pm), "+s"(eu.pn));
        if (carry) { if constexpr (Epi::MID) E.mid(acc, eu, wr, wc, fr, fq); }
        else if constexpr (Epi::FINAL) E.run_final(acc, eu, wr, wc, fr, fq);
        else E.run(AccSrc{acc}, eu, wr, wc, fr, fq);
        S.done(cur);
        if (!has_next) break;
        if (!carry) {
#pragma unroll
        for (int a = 0; a < 2; ++a)
#pragma unroll
            for (int b = 0; b < 2; ++b)
#pragma unroll
                for (int m = 0; m < 4; ++m)
#pragma unroll
                    for (int n = 0; n < 2; ++n) acc[a][b][m][n] = (f32x4){0.f, 0.f, 0.f, 0.f};
        }
        cur = nxt; cA = nA; cB = nB; ++ui;
        if constexpr (ALIGN_EPI) { if (wr == 1) PG8_BAR; }
    }
    PG8_WAIT_V(0);
    if constexpr (!ALIGN_EPI) { if (wr == 0) PG8_BAR; }
    PG8_BAR;
#undef PG8_SA
#undef PG8_SB
#undef PG8_STAGE
#undef PG8_LDA
#undef PG8_LDB
#undef PG8_MMA
#undef PG8_WAIT_V
#undef PG8_WAIT_L
#undef PG8_BAR
#undef PG8_SCHED
}
}

constexpr int NWAVES = 8;
constexpr int PER_PHASE = 11;
constexpr int N_LAUNCHES = MK_N_LAUNCHES;

#define GAS __attribute__((address_space(1)))
#define LAS __attribute__((address_space(3)))
typedef unsigned short bf16;
typedef unsigned v4u __attribute__((ext_vector_type(4)));
typedef unsigned v2u __attribute__((ext_vector_type(2)));
typedef float f32x4 __attribute__((ext_vector_type(4)));
typedef float f32x16 __attribute__((ext_vector_type(16)));
typedef short bf16x8 __attribute__((ext_vector_type(8)));
typedef short s16x4 __attribute__((ext_vector_type(4)));
typedef GAS unsigned gu32;
#define RLX_AGENT __ATOMIC_RELAXED, __HIP_MEMORY_SCOPE_AGENT
#define LDS_WAIT() asm volatile("s_waitcnt lgkmcnt(0)" ::: "memory")
#define VM_WAIT() asm volatile("s_waitcnt vmcnt(0)" ::: "memory")
using pg8::pk2; using pg8::pk4;

constexpr size_t MiB = 1u << 20;
constexpr size_t al(size_t x) { return (x + MiB - 1) / MiB * MiB; }
constexpr size_t WS_CTL = 0, CTL_ZERO_BYTES = 1 * MiB;
constexpr size_t WS_W1C = 1 * MiB;
constexpr size_t WS_W1D = WS_W1C + al((size_t)NCAT * DM * 2);
constexpr size_t WS_WIN = WS_W1D + al((size_t)DM * FF * 2);
constexpr size_t WS_WOUT = WS_WIN + al((size_t)NIN * DM * 2);
constexpr size_t WS_W2C = WS_WOUT + al((size_t)DM * DM * 2);
constexpr size_t WS_W2D = WS_W2C + al((size_t)NCAT * DM * 2);
constexpr size_t WS_WPG = WS_W2D + al((size_t)DM * FF * 2);
constexpr size_t WS_WPP = WS_WPG + al((size_t)DM * DM * 2);
constexpr size_t WS_WPOOL = WS_WPP + al((size_t)DM * PLE * 2);
constexpr size_t WS_HB = WS_WPOOL + al((size_t)PWID * 256 * 2);
constexpr size_t WS_G = WS_HB + al((size_t)M * DM * 2);
constexpr size_t WS_QB = WS_G + al((size_t)M * FF * 2);
constexpr size_t WS_KB = WS_QB + al((size_t)M * SBW * 2);
constexpr size_t WS_VB = WS_KB + al((size_t)M * SBW * 2);
constexpr size_t WS_XP = WS_VB + al((size_t)M * SBW * 2);
constexpr size_t WS_PLB = WS_XP + al((size_t)M * PWID * 2);
constexpr size_t WS_C = WS_PLB + al((size_t)M * PWID * 2);
constexpr size_t WS_PROJ = WS_C + al((size_t)M * DM * 2);
constexpr size_t WS_PB = WS_PROJ + al((size_t)M * DM * 2);
constexpr size_t WS_SLAB = WS_PB + al((size_t)M * PLE * 2);
constexpr size_t WS_END = WS_SLAB + 4 * MiB;
constexpr int CW_BAR = 4096;
constexpr int CW_RANK = 12288;
constexpr int CW_CNT = 8192;
constexpr int CW_SSQ = 16384;
constexpr int SSQ_STRIDE = 8704;
static_assert((CW_SSQ + 7 * SSQ_STRIDE) * 4 <= (int)CTL_ZERO_BYTES && SSQ_STRIDE >= M, "CTL words inside the memset region");

constexpr int RING_OFF = 0, RING_BYTES = 131072;
constexpr int LDSCTL_OFF = RING_BYTES, MISC_OFF = LDSCTL_OFF + 320;
constexpr int LDS_BYTES = 147456;

__device__ __forceinline__ float wave_sum(float v) {
#pragma unroll
    for (int o = 1; o < 64; o <<= 1) v += __shfl_xor(v, o);
    return v;
}

#define XB_TMO      128
#define XB_XCNT(j)  (256  + 64 * (j))
#define XB_XSUB(j)  (1280 + 64 * (j))
#define XB_XGEN(j)  (2304 + 64 * (j))
#define XB_TOP      3328
#define XB_TOPGEN   3392
#define XCD_BAR_WORDS 3456
#define XB_SPIN_CAP (1u << 18)
__device__ __forceinline__ unsigned xb_ld(unsigned* p)              { return __hip_atomic_load(p, __ATOMIC_RELAXED, __HIP_MEMORY_SCOPE_AGENT); }
__device__ __forceinline__ unsigned xb_add(unsigned* p, unsigned v) { return __hip_atomic_fetch_add(p, v, __ATOMIC_RELAXED, __HIP_MEMORY_SCOPE_AGENT); }
__device__ __forceinline__ unsigned xb_xcc_id() { return (unsigned)__builtin_amdgcn_s_getreg((3 << 11) | 20) & 0xFu; }
#define XB_SPIN(cond, bar) do { unsigned _sp = 0; while (cond) { __builtin_amdgcn_s_sleep(1); \
    if ((++_sp & 255u) == 0u) { if (xb_ld(&(bar)[XB_TMO])) break; if (_sp > XB_SPIN_CAP) { atomicAdd(&(bar)[XB_TMO], 1u); break; } } } } while (0)
struct XcdBarrier { unsigned* bar; unsigned x; volatile LAS unsigned* st; };
__device__ __forceinline__ XcdBarrier xcd_barrier_post(unsigned* bar, volatile LAS unsigned* st) {
    XcdBarrier b; b.bar = bar; b.x = xb_xcc_id(); b.st = st;
    if (threadIdx.x == 0) (void)xb_add(&bar[XB_XCNT(b.x)], 1u);
    return b;
}
__device__ __forceinline__ void xcd_barrier_complete(unsigned* bar, unsigned x, unsigned& nloc, unsigned& nx) {
    const unsigned G = gridDim.x * gridDim.y * gridDim.z;
    unsigned sum, cnt, mine, sp = 0u;
    for (;;) {
        sum = 0u; cnt = 0u; mine = 0u;
#pragma unroll
        for (unsigned j = 0; j < 16; ++j) { const unsigned c = xb_ld(&bar[XB_XCNT(j)]); sum += c; cnt += (c > 0u) ? 1u : 0u; mine = (j == x) ? c : mine; }
        if (sum == G) break;
        __builtin_amdgcn_s_sleep(1);
        if ((++sp & 255u) == 0u) { if (xb_ld(&bar[XB_TMO])) break; if (sp > XB_SPIN_CAP) { atomicAdd(&bar[XB_TMO], 1u); break; } }
    }
    nloc = mine > 0u ? mine : 1u; nx = cnt > 0u ? cnt : 1u;
}
__device__ __forceinline__ void xcd_barrier(const XcdBarrier& b) {
    asm volatile("s_waitcnt vmcnt(0)" ::: "memory");
    __syncthreads();
    if (threadIdx.x == 0) {
        unsigned* bar = b.bar;
        __builtin_amdgcn_s_waitcnt(0);
        unsigned nloc = b.st[0], nx = b.st[1];
        if (nloc == 0u) { xcd_barrier_complete(bar, b.x, nloc, nx); b.st[0] = nloc; b.st[1] = nx; }
        const unsigned old = xb_add(&bar[XB_XSUB(b.x)], 1u);
        const unsigned gen = old / nloc;
        if (old + 1u == (gen + 1u) * nloc) {
            __builtin_amdgcn_fence(__ATOMIC_RELEASE, "agent");
            asm volatile("s_waitcnt vmcnt(0)" ::: "memory");
            const unsigned og = xb_add(&bar[XB_TOP], 1u);
            const unsigned tg = og / nx;
            if (og + 1u == (tg + 1u) * nx) xb_add(&bar[XB_TOPGEN], 1u);
            else XB_SPIN(xb_ld(&bar[XB_TOPGEN]) == tg, bar);
            __builtin_amdgcn_fence(__ATOMIC_ACQUIRE, "agent");
            xb_add(&bar[XB_XGEN(b.x)], 1u);
            asm volatile("s_waitcnt vmcnt(0)" ::: "memory");
        } else {
            XB_SPIN(xb_ld(&bar[XB_XGEN(b.x)]) == gen, bar);
            __builtin_amdgcn_fence(__ATOMIC_ACQUIRE, "agent");
            asm volatile("s_waitcnt vmcnt(0)" ::: "memory");
        }
    }
    __syncthreads();
}

struct Frame {
    LAS unsigned char* lds;
    volatile LAS unsigned* MISC;
    unsigned* ctl; unsigned char* ws;
    int tid, lane, wave, vcu, G;
    const float* in[25];
    float* out;
    bf16 *W1C, *W1D, *WIN, *WOUT, *W2C, *W2D, *WPG, *WPP, *WPOOL;
    bf16 *HB, *GB, *QB, *KB, *VB, *PLB, *CB, *PROJ, *PB;
    bf16* XP;
    float *ssq0, *ssq1, *ssqA, *ssqP, *ssq2, *ssq3, *ssq4;
};
enum { I_XP = 0, I_XS, I_CK, I_CV, I_SPOOL, I_PP, I_PS, I_GFFN1, I_W1G, I_W1U, I_W1D, I_GMIX, I_WIN, I_GATT, I_WPOOL, I_PSCALE, I_WOUT, I_GFFN2, I_W2G, I_W2U, I_W2D, I_GPLE, I_WPG, I_WPP, I_GFINAL };

constexpr int TRP = 66;
__device__ __forceinline__ void tr_item(const float* W, int N, const float* ga, bf16* WT, int Kdst, int k0, int n0, int drow0, LAS unsigned short* scr, int lane) {
    const int r4 = lane >> 4, c4 = lane & 15;
    f32x4 v[16];
#pragma unroll
    for (int i = 0; i < 16; ++i) v[i] = __builtin_nontemporal_load((const GAS f32x4*)(W + (size_t)(k0 + 4 * i + r4) * N + n0 + 4 * c4));
#pragma unroll
    for (int i = 0; i < 16; ++i) { f32x4 x = v[i]; if (ga) x = x * ga[k0 + 4 * i + r4];
        const v2u w = pk4(x); LAS unsigned* d = (LAS unsigned*)(scr + (4 * i + r4) * TRP + 4 * c4); d[0] = w.x; d[1] = w.y; }
    LDS_WAIT(); asm volatile("" ::: "memory");
    const int c = lane & 7;
#pragma unroll
    for (int j = 0; j < 8; ++j) { const int n = (lane >> 3) + 8 * j; const LAS unsigned short* p = scr + (8 * c) * TRP + n;
        v4u o; o.x = (unsigned)p[0] | ((unsigned)p[TRP] << 16); o.y = (unsigned)p[2 * TRP] | ((unsigned)p[3 * TRP] << 16); o.z = (unsigned)p[4 * TRP] | ((unsigned)p[5 * TRP] << 16); o.w = (unsigned)p[6 * TRP] | ((unsigned)p[7 * TRP] << 16);
        *(GAS v4u*)(WT + (size_t)(drow0 + n) * Kdst + k0 + 8 * c) = o; }
    LDS_WAIT(); asm volatile("" ::: "memory");
}
__device__ __forceinline__ void tr_plain(const float* W, int K, int N, const float* ga, const float* gb, int ghalf, bf16* WT, int r, LAS unsigned short* scr, int lane) {
    const int nblk = N / 64, kb = r / nblk, nb = r % nblk; const float* gk = (64 * kb < ghalf) ? ga : gb;
    tr_item(W, N, gk, WT, K, 64 * kb, 64 * nb, 64 * nb, scr, lane);
}
__device__ __forceinline__ void tr_cat(const float* W, const float* ga, bf16* WT, int half, int r, LAS unsigned short* scr, int lane) {
    const int nblk = FF / 64, kb = r / nblk, nb = r % nblk, n0 = 64 * nb; tr_item(W, FF, ga, WT, DM, 64 * kb, n0, (n0 >> 7) * 256 + half * 128 + (n0 & 127), scr, lane);
}
__device__ __forceinline__ void p0_prologue(Frame& F) {
    LAS unsigned short* scr = (LAS unsigned short*)(F.lds + RING_OFF + F.wave * 16384);
    const int gw = F.vcu * NWAVES + F.wave, NGW = F.G * NWAVES;
    constexpr int I_CAT = (DM / 64) * (FF / 64), I_DN = (FF / 64) * (DM / 64), I_IN = (DM / 64) * (NIN / 64), I_SQ = (DM / 64) * (DM / 64), I_PPJ = (PLE / 64) * (DM / 64), I_PL = 4 * (256 / 64) * (256 / 64);
    constexpr int NITEMS = 4 * I_CAT + 2 * I_DN + I_IN + 2 * I_SQ + I_PPJ + I_PL;
    constexpr int NLATE = NITEMS - 2 * I_CAT;
    for (int it = gw; it < NLATE; it += NGW) {
        int r = it;
        if (r < I_SQ) { tr_plain(F.in[I_WPG], DM, DM, F.in[I_GPLE], nullptr, 1 << 30, F.WPG, r, scr, F.lane); continue; } r -= I_SQ;
        if (r < I_DN) { tr_plain(F.in[I_W2D], FF, DM, nullptr, nullptr, 0, F.W2D, r, scr, F.lane); continue; } r -= I_DN;
        if (r < I_CAT) { tr_cat(F.in[I_W2U], F.in[I_GFFN2], F.W2C, 1, r, scr, F.lane); continue; } r -= I_CAT;
        if (r < I_CAT) { tr_cat(F.in[I_W2G], F.in[I_GFFN2], F.W2C, 0, r, scr, F.lane); continue; } r -= I_CAT;
        if (r < I_SQ) { tr_plain(F.in[I_WOUT], DM, DM, F.in[I_GATT], F.in[I_PSCALE] - SBW, SBW, F.WOUT, r, scr, F.lane); continue; } r -= I_SQ;
        if (r < I_PL) { const int g = r / 16, rr = r % 16; tr_plain(F.in[I_WPOOL] + (size_t)g * 65536, 256, 256, nullptr, nullptr, 0, F.WPOOL + (size_t)g * 65536, rr, scr, F.lane); continue; } r -= I_PL;
        if (r < I_IN) { tr_plain(F.in[I_WIN], DM, NIN, F.in[I_GMIX], nullptr, 1 << 30, F.WIN, r, scr, F.lane); continue; } r -= I_IN;
        if (r < I_DN) { tr_plain(F.in[I_W1D], FF, DM, nullptr, nullptr, 0, F.W1D, r, scr, F.lane); continue; } r -= I_DN;
        tr_plain(F.in[I_WPP], PLE, DM, nullptr, nullptr, 0, F.WPP, r, scr, F.lane);
    }
    for (int m0 = gw; m0 < M; m0 += 2 * NGW) {
        const int m1 = m0 + NGW; const bool two = m1 < M;
        const float* xr0 = (m0 < MP) ? F.in[I_XP] + (size_t)m0 * DM : F.in[I_XS] + (size_t)(m0 - MP) * DM;
        const float* pr0 = (m0 < MP) ? F.in[I_PP] + (size_t)m0 * PLE : F.in[I_PS] + (size_t)(m0 - MP) * PLE;
        const int mm1 = two ? m1 : m0;
        const float* xr1 = (mm1 < MP) ? F.in[I_XP] + (size_t)mm1 * DM : F.in[I_XS] + (size_t)(mm1 - MP) * DM;
        const float* pr1 = (mm1 < MP) ? F.in[I_PP] + (size_t)mm1 * PLE : F.in[I_PS] + (size_t)(mm1 - MP) * PLE;
        f32x4 v0[8], v1[8]; float s0 = 0.f, s1 = 0.f;
#pragma unroll
        for (int j = 0; j < 8; ++j) { v0[j] = __builtin_nontemporal_load((const GAS f32x4*)xr0 + F.lane + 64 * j); v1[j] = __builtin_nontemporal_load((const GAS f32x4*)xr1 + F.lane + 64 * j); }
        const f32x4 p0 = ((const GAS f32x4*)pr0)[F.lane], p1 = ((const GAS f32x4*)pr1)[F.lane];
#pragma unroll
        for (int j = 0; j < 8; ++j) { s0 += pg8::dot4(v0[j]); s1 += pg8::dot4(v1[j]); }
        s0 = wave_sum(s0); s1 = wave_sum(s1);
        if (F.lane == 0) { F.ssq0[m0] = s0; if (two) F.ssq0[m1] = s1; }
        GAS v2u* o0 = (GAS v2u*)(F.HB + (size_t)m0 * DM) + F.lane; GAS v2u* o1 = (GAS v2u*)(F.HB + (size_t)mm1 * DM) + F.lane;
#pragma unroll
        for (int j = 0; j < 8; ++j) o0[64 * j] = pk4(v0[j]);
        ((GAS v2u*)(F.PB + (size_t)m0 * PLE))[F.lane] = pk4(p0);
        if (two) {
#pragma unroll
            for (int j = 0; j < 8; ++j) o1[64 * j] = pk4(v1[j]);
            ((GAS v2u*)(F.PB + (size_t)m1 * PLE))[F.lane] = pk4(p1); }
    }
    for (int it = gw; it < 2 * I_CAT; it += NGW) { if (it < I_CAT) tr_cat(F.in[I_W1G], F.in[I_GFFN1], F.W1C, 0, it, scr, F.lane); else tr_cat(F.in[I_W1U], F.in[I_GFFN1], F.W1C, 1, it - I_CAT, scr, F.lane); }
}

__device__ __forceinline__ int crow(int r, int hi) { return (r & 3) + 8 * (r >> 2) + 4 * hi; }
__device__ __forceinline__ bf16x8 cvt8(f32x4 a, f32x4 b) { v4u w; w.x = pk2(a[0], a[1]); w.y = pk2(a[2], a[3]); w.z = pk2(b[0], b[1]); w.w = pk2(b[2], b[3]); return __builtin_bit_cast(bf16x8, w); }
typedef short v4i16_t __attribute__((ext_vector_type(4)));
__device__ __forceinline__ s16x4 vtr(LAS const unsigned char* p) { return __builtin_bit_cast(s16x4, __builtin_amdgcn_ds_read_tr16_b64_v4i16((LAS v4i16_t*)p)); }
constexpr int VPITCH = 272;
constexpr int VIMG_BYTES = 32 * VPITCH;
constexpr float SB_STOP = -135.0f;
constexpr int TA_S = 5;

template <bool SAMPLE>
__device__ __forceinline__ void sb_unit(const Frame& F, int b, int h, int qblk, LAS unsigned char* vl, bool dry = false) {
    const int lane = F.lane, qi = lane & 31, hi = lane >> 5;
    const int qrow = SAMPLE ? MP + b * DECS + qi : b * SEQ + qblk * 32 + qi;
    const bf16* qp = F.QB + (size_t)qrow * SBW + h * HD + hi * 8;
    bf16x8 qreg[8];
    if (!SAMPLE) {
#pragma unroll
        for (int ds = 0; ds < 8; ++ds) qreg[ds] = *(const bf16x8*)(qp + ds * 16); }
    f32x16 o[4];
#pragma unroll
    for (int db = 0; db < 4; ++db)
#pragma unroll
        for (int r = 0; r < 16; ++r) o[db][r] = 0.f;
    float R = 0.f;
    const int nblk = SAMPLE ? (PAST / 32 + 1) : qblk + 1;
    const int tr_base = ((4 * (lane >> 5) + ((lane & 15) >> 2)) * VPITCH) + (16 * ((lane >> 4) & 1) + 4 * (lane & 3)) * 2;
    const int srow0 = SAMPLE ? MP + b * DECS : b * SEQ;
    bf16x8 kf[8];
    if (!SAMPLE) { const bf16* kp = F.KB + (size_t)(srow0 + (nblk - 1) * 32 + qi) * SBW + h * HD + hi * 8;
#pragma unroll
      for (int ds = 0; ds < 8; ++ds) kf[ds] = *(const bf16x8*)(kp + ds * 16); }
    { unsigned tx = 0;
      if (!SAMPLE) { unsigned tch[2 * 4];
#pragma unroll
          for (int i = 0; i < 4; ++i) { const int jb = (nblk - 3 - i > 0) ? nblk - 3 - i : 0; const size_t ro = (size_t)(srow0 + jb * 32 + (lane & 31)) * SBW + h * HD + (lane >> 5) * 32;
              tch[2 * i] = *(const GAS unsigned*)(F.KB + ro); tch[2 * i + 1] = *(const GAS unsigned*)(F.KB + ro + 64); }
#pragma unroll
          for (int i = 0; i < 8; ++i) tx ^= tch[i];
      }
      if (SAMPLE) { unsigned tch[8 * TA_S + 4];
          { const size_t ro = (size_t)(srow0 + (lane & 31)) * SBW + h * HD + (lane >> 5) * 32;
            tch[8 * TA_S] = *(const GAS unsigned*)(F.KB + ro); tch[8 * TA_S + 1] = *(const GAS unsigned*)(F.KB + ro + 64); tch[8 * TA_S + 2] = *(const GAS unsigned*)(F.VB + ro); tch[8 * TA_S + 3] = *(const GAS unsigned*)(F.VB + ro + 64); }
#pragma unroll
          for (int i = 0; i < TA_S; ++i) { const size_t ro = (size_t)(b * PAST + (PAST / 32 - 1 - i) * 32 + (lane & 31)) * SBW + h * HD + (lane >> 5) * 16;
#pragma unroll
              for (int t = 0; t < 4; ++t) { tch[8 * i + t] = *(const GAS unsigned*)(F.in[I_CK] + ro + t * 32); tch[8 * i + 4 + t] = *(const GAS unsigned*)(F.in[I_CV] + ro + t * 32); } }
#pragma unroll
          for (int i = 0; i < 8 * TA_S + 4; ++i) tx ^= tch[i];
      }
      asm volatile("" :: "v"(tx)); }
    const unsigned vby_f32 = (unsigned)((lane >> 5) * SBW + (lane & 31) * 4) * 4u;
    const unsigned vby_b16 = (unsigned)((lane >> 4) * SBW + (lane & 15) * 8) * 2u;
    LAS unsigned char* const vl_f32 = vl + (lane >> 5) * VPITCH + (lane & 31) * 8;
    LAS unsigned char* const vl_b16 = vl + (lane >> 4) * VPITCH + (lane & 15) * 16;
    v4u vr[8];
    if (!SAMPLE) {
        const bf16* vp = F.VB + (size_t)(srow0 + (nblk - 1) * 32) * SBW + h * HD;
#pragma unroll
        for (int i = 0; i < 8; ++i) { const char* pb = (const char*)vp + (size_t)i * 4 * SBW * 2; asm volatile("" : "+s"(pb)); vr[i] = *(const GAS v4u*)(pb + vby_b16); } }
    for (int j = nblk - 1; j >= 0; --j) {
        const bool diag = (j == nblk - 1);
        const bool from_cache = SAMPLE && !diag;
        f32x16 st;
#pragma unroll
        for (int r = 0; r < 16; ++r) st[r] = 0.f;
        if (!from_cache) {
            if (SAMPLE) { const bf16* vp = F.VB + (size_t)srow0 * SBW + h * HD;
#pragma unroll
            for (int i = 0; i < 8; ++i) { const char* pb = (const char*)vp + (size_t)i * 4 * SBW * 2; asm volatile("" : "+s"(pb)); vr[i] = *(const GAS v4u*)(pb + vby_b16); } }
            else {
#pragma unroll
                for (int i = 0; i < 8; ++i) *(LAS v4u*)(vl_b16 + i * 4 * VPITCH) = vr[i];
                if (j > 0) { const bf16* vp = F.VB + (size_t)(srow0 + (j - 1) * 32) * SBW + h * HD;
#pragma unroll
                    for (int i = 0; i < 8; ++i) { const char* pb = (const char*)vp + (size_t)i * 4 * SBW * 2; asm volatile("" : "+s"(pb)); vr[i] = *(const GAS v4u*)(pb + vby_b16); } } }
            if (SAMPLE) { const bf16* kp = F.KB + (size_t)(srow0 + qi) * SBW + h * HD + hi * 8;
#pragma unroll
                for (int ds = 0; ds < 8; ++ds) kf[ds] = *(const bf16x8*)(kp + ds * 16); }
#pragma unroll
            for (int ds = 0; ds < 8; ++ds) { bf16x8 qf; if (SAMPLE) qf = *(const bf16x8*)(qp + ds * 16); else qf = qreg[ds]; st = __builtin_amdgcn_mfma_f32_32x32x16_bf16(kf[ds], qf, st, 0, 0, 0); }
            if (!SAMPLE && j > 0) {
                const bf16* kp = F.KB + (size_t)(srow0 + (j - 1) * 32 + qi) * SBW + h * HD + hi * 8;
#pragma unroll
                for (int ds = 0; ds < 8; ++ds) kf[ds] = *(const bf16x8*)(kp + ds * 16); }
        } else {
            const float* kp = F.in[I_CK] + ((size_t)(b * PAST + j * 32 + qi) * SBW + h * HD + hi * 8);
            const float* vp = F.in[I_CV] + ((size_t)(b * PAST + j * 32) * SBW + h * HD);
#pragma unroll
            for (int hf = 0; hf < 2; ++hf) { f32x4 ka[4], kb[4];
#pragma unroll
              for (int d4 = 0; d4 < 4; ++d4) { ka[d4] = *(const f32x4*)(kp + (hf * 4 + d4) * 16); kb[d4] = *(const f32x4*)(kp + (hf * 4 + d4) * 16 + 4); }
#pragma unroll
              for (int d4 = 0; d4 < 4; ++d4) { const bf16x8 qf = *(const bf16x8*)(qp + (hf * 4 + d4) * 16); st = __builtin_amdgcn_mfma_f32_32x32x16_bf16(cvt8(ka[d4], kb[d4]), qf, st, 0, 0, 0); }
              asm volatile("" ::: "memory"); }
            { f32x4 vf[16];
#pragma unroll
              for (int i = 0; i < 16; ++i) { const char* pb = (const char*)vp + (size_t)i * 2 * SBW * 4; asm volatile("" : "+s"(pb)); vf[i] = *(const GAS f32x4*)(pb + vby_f32); }
#pragma unroll
              for (int i = 0; i < 16; ++i) *(LAS v2u*)(vl_f32 + i * 2 * VPITCH) = pk4(vf[i]); }
            asm volatile("" ::: "memory");
        }
        bf16x8 vaf[2][2];
        if (!SAMPLE) {
#pragma unroll
            for (int db = 0; db < 2; ++db)
#pragma unroll
                for (int s = 0; s < 2; ++s) { const LAS unsigned char* p = vl + tr_base + (16 * s) * VPITCH + db * 64;
                    const s16x4 lo = vtr(p), hi4 = vtr(p + 8 * VPITCH);
                    vaf[db][s] = (bf16x8){lo[0], lo[1], lo[2], lo[3], hi4[0], hi4[1], hi4[2], hi4[3]}; }
        }
        float bt[16], om[16];
#pragma unroll
        for (int r = 0; r < 16; ++r) { const float z = fmaxf(st[r], -125.0f);
            const float t = __builtin_amdgcn_exp2f(-z); float b_ = __builtin_amdgcn_rcpf(1.0f + t); float o_ = t * b_;
            if (diag && !(crow(r, hi) < qi)) { b_ = 0.f; o_ = 1.f; }
            bt[r] = b_; om[r] = o_; }
        float e[16], gs[4], pg[4];
#pragma unroll
        for (int g = 0; g < 4; ++g) { e[4 * g + 3] = 1.f; e[4 * g + 2] = om[4 * g + 3]; e[4 * g + 1] = e[4 * g + 2] * om[4 * g + 2]; e[4 * g] = e[4 * g + 1] * om[4 * g + 1]; gs[g] = e[4 * g] * om[4 * g]; }
#pragma unroll
        for (int g = 0; g < 4; ++g) pg[g] = __shfl_xor(gs[g], 32);
        const float scale = __builtin_amdgcn_exp2f(R);
        float after = 1.f; float a[16];
#pragma unroll
        for (int g = 3; g >= 0; --g) { const float tail = scale * after * (hi == 0 ? pg[g] : 1.f);
#pragma unroll
            for (int i = 0; i < 4; ++i) { const int r = 4 * g + i; a[r] = bt[r] * e[r] * tail; }
            after *= gs[g] * pg[g]; }
        R += __builtin_amdgcn_logf(after);
        bf16x8 xf[2];
#pragma unroll
        for (int s = 0; s < 2; ++s) { v4u w; w.x = pk2(a[8 * s + 0], a[8 * s + 1]); w.y = pk2(a[8 * s + 2], a[8 * s + 3]); w.z = pk2(a[8 * s + 4], a[8 * s + 5]); w.w = pk2(a[8 * s + 6], a[8 * s + 7]); xf[s] = __builtin_bit_cast(bf16x8, w); }
        asm volatile("" ::: "memory");
        if (SAMPLE && !from_cache) {
#pragma unroll
            for (int i = 0; i < 8; ++i) *(LAS v4u*)(vl_b16 + i * 4 * VPITCH) = vr[i];
        }
        LDS_WAIT();
#pragma unroll
        for (int db = 0; db < 4; ++db)
#pragma unroll
            for (int s = 0; s < 2; ++s) { bf16x8 va;
                if (!SAMPLE && db < 2) va = vaf[db][s];
                else { const LAS unsigned char* p = vl + tr_base + (16 * s) * VPITCH + db * 64;
                    const s16x4 lo = vtr(p), hi4 = vtr(p + 8 * VPITCH);
                    va = (bf16x8){lo[0], lo[1], lo[2], lo[3], hi4[0], hi4[1], hi4[2], hi4[3]}; }
                o[db] = __builtin_amdgcn_mfma_f32_32x32x16_bf16(va, xf[s], o[db], 0, 0, 0); }
        LDS_WAIT(); asm volatile("" ::: "memory");
        if (__all(R < SB_STOP)) break;
    }
    float s = 0.f;
#pragma unroll
    for (int db = 0; db < 4; ++db)
#pragma unroll
        for (int r = 0; r < 16; ++r) s += o[db][r] * o[db][r];
    s += __shfl_xor(s, 32);
    if (hi == 0 && !dry) atomicAdd(F.ssqA + qrow, s);
    bf16* cp = F.CB + (size_t)qrow * DM + h * HD + 4 * hi;
#pragma unroll
    for (int db = 0; db < 4; ++db)
#pragma unroll
        for (int g = 0; g < 4; ++g) { v2u w; w.x = pk2(o[db][4 * g], o[db][4 * g + 1]); w.y = pk2(o[db][4 * g + 2], o[db][4 * g + 3]); *(v2u*)(cp + 32 * db + 8 * g) = w; }
}

__device__ __forceinline__ f32x4 ld_bf4(const bf16* p) { const v2u w = *(const v2u*)p; return (f32x4){pg8::bf_lo(w.x), pg8::bf_hi(w.x), pg8::bf_lo(w.y), pg8::bf_hi(w.y)}; }
template <int W>
__device__ __forceinline__ void pool_chunk(const bf16* xsrc, const float* past, int t0, int L, int pos0, bf16* dst, int g, int lane) {
    const int c = g * 256 + lane * 4;
    f32x4 hist[16];
#pragma unroll
    for (int j = 0; j < 16; ++j) { const int t = t0 - 16 + j; f32x4 v = (f32x4){0.f, 0.f, 0.f, 0.f};
        if (t >= 0) v = ld_bf4(xsrc + (size_t)t * PWID + c); else if (past && t >= -PSTATE) v = *(const f32x4*)(past + (size_t)(PSTATE + t) * PWID + c);
        hist[j] = v; }
    f32x4 S = (f32x4){0.f, 0.f, 0.f, 0.f};
#pragma unroll
    for (int i = 1; i <= W; ++i) S += hist[16 - i];
    for (int tb = t0; tb < t0 + L; tb += 16) {
        v2u xraw[16];
#pragma unroll
        for (int j = 0; j < 16; ++j) xraw[j] = *(const v2u*)(xsrc + (size_t)(tb + j) * PWID + c);
#pragma unroll
        for (int j = 0; j < 16; ++j) { const int t = tb + j; const f32x4 xn = (f32x4){pg8::bf_lo(xraw[j].x), pg8::bf_hi(xraw[j].x), pg8::bf_lo(xraw[j].y), pg8::bf_hi(xraw[j].y)};
            S += xn - hist[(j - W) & 15]; hist[j] = xn;
            const int pc = pos0 + t + 1; const float cnt = (float)(pc < W ? pc : W);
            const float icnt = 1.0f / cnt; const f32x4 pooled = S * icnt - xn;
            *(v2u*)(dst + (size_t)t * PWID + c) = pk4(pooled); }
    }
}
__device__ __forceinline__ void pool_unit(const Frame& F, int id) {
    const bf16* xsrc; const float* past = nullptr; bf16* dst; int t0, L, pos0, g;
    if (id < 512) { const int b = id >> 7; g = (id >> 5) & 3; const int ch = id & 31; xsrc = F.XP + (size_t)b * SEQ * PWID; dst = F.PLB + (size_t)b * SEQ * PWID; t0 = ch * 64; L = 64; pos0 = 0; }
    else { const int k = id - 512, b = k >> 2; g = k & 3; xsrc = F.XP + (size_t)(MP + b * DECS) * PWID; dst = F.PLB + (size_t)(MP + b * DECS) * PWID; past = F.in[I_SPOOL] + (size_t)b * PSTATE * PWID; t0 = 0; L = DECS; pos0 = PAST; }
    if (g == 0) pool_chunk<2>(xsrc, past, t0, L, pos0, dst, g, F.lane);
    else if (g == 1) pool_chunk<4>(xsrc, past, t0, L, pos0, dst, g, F.lane);
    else if (g == 2) pool_chunk<8>(xsrc, past, t0, L, pos0, dst, g, F.lane);
    else pool_chunk<16>(xsrc, past, t0, L, pos0, dst, g, F.lane);
}

__device__ __forceinline__ void publish_count(unsigned* cnt) {
    VM_WAIT(); __syncthreads();
    if (threadIdx.x == 0) { __builtin_amdgcn_fence(__ATOMIC_RELEASE, "agent"); VM_WAIT(); (void)__hip_atomic_fetch_add(cnt, 1u, __ATOMIC_RELAXED, __HIP_MEMORY_SCOPE_AGENT); }
}
__device__ __forceinline__ void wait_count(unsigned* cnt, unsigned need, unsigned* tmo) {
    if (threadIdx.x == 0) { unsigned sp = 0;
        while (__hip_atomic_load(cnt, __ATOMIC_RELAXED, __HIP_MEMORY_SCOPE_AGENT) < need) { __builtin_amdgcn_s_sleep(8); if (++sp > (1u << 22)) { atomicAdd(tmo, 1u); break; } }
        __builtin_amdgcn_fence(__ATOMIC_ACQUIRE, "agent"); VM_WAIT(); }
    __syncthreads();
}

__device__ __forceinline__ void xcd_local_barrier(unsigned* cntx, unsigned nloc, unsigned* tmo) {
    VM_WAIT(); __syncthreads();
    if (threadIdx.x == 0) {
        const unsigned old = __hip_atomic_fetch_add(cntx, 1u, __ATOMIC_RELAXED, __HIP_MEMORY_SCOPE_AGENT); const unsigned want = (old / nloc + 1u) * nloc; unsigned sp = 0;
        while (__hip_atomic_load(cntx, __ATOMIC_RELAXED, __HIP_MEMORY_SCOPE_AGENT) < want) { __builtin_amdgcn_s_sleep(1); if (++sp > (1u << 21)) { atomicAdd(tmo, 1u); break; } }
        __builtin_amdgcn_fence(__ATOMIC_ACQUIRE, "agent"); VM_WAIT(); }
    __syncthreads();
}

struct EpiPleFinal {
    static constexpr bool AFTER_DRAIN = false, MID = false, FINAL = true;
    float* y; const pg8::bf16_t* hb; const pg8::bf16_t* proj; const float* ssq; float inv_w; float* ssq4; const float* gfin;
    int mode; unsigned* cnt; unsigned need; unsigned* tmo; XcdBarrier bar;
    template <class Src> __device__ __forceinline__ void run(const Src&, const pg8::Unit&, int, int, int, int) const {}
    __device__ __forceinline__ void run_final(pg8::f32x4 (&acc)[2][2][4][2], const pg8::Unit& u, int wr, int wc, int fr, int fq) const {
        using namespace pg8;
        const int row0 = u.pm * BM + wr * 64 + fr, col0 = u.pn * BM + wc * 32 + 4 * fq;
        { float rsv[2][4]; row_scales(ssq, inv_w, row0, rsv);
#pragma unroll
          for (int ai = 0; ai < 2; ++ai) {
            u32x2 hw[4][2][2], pj[4][2][2];
#pragma unroll
            for (int m = 0; m < 4; ++m)
#pragma unroll
                for (int bj = 0; bj < 2; ++bj)
#pragma unroll
                    for (int n = 0; n < 2; ++n) { const size_t o = (size_t)(row0 + ai * HALF + m * 16) * DM + col0 + bj * HALF + n * 16; hw[m][bj][n] = *(const u32x2*)(hb + o); pj[m][bj][n] = *(const u32x2*)(proj + o); }
#pragma unroll
            for (int m = 0; m < 4; ++m) { const int row = row0 + ai * HALF + m * 16; const float r = rsv[ai][m]; float s = 0.f;
#pragma unroll
                for (int bj = 0; bj < 2; ++bj)
#pragma unroll
                    for (int n = 0; n < 2; ++n) { const u32x2 w = hw[m][bj][n], p = pj[m][bj][n]; const f32x4 b = (f32x4){bf_lo(w.x), bf_hi(w.x), bf_lo(w.y), bf_hi(w.y)};
                        const f32x4 g = acc[ai][bj][m][n] * r; f32x4 v;
                        v[0] = b[0] + sigmoidf_(g[0]) * bf_lo(p.x); v[1] = b[1] + sigmoidf_(g[1]) * bf_hi(p.x); v[2] = b[2] + sigmoidf_(g[2]) * bf_lo(p.y); v[3] = b[3] + sigmoidf_(g[3]) * bf_hi(p.y);
                        acc[ai][bj][m][n] = v; s += dot4(v); }
                s += __shfl_xor(s, 16); s += __shfl_xor(s, 32); if (fq == 0) atomicAdd(ssq4 + row, s); }
          } }
        if (mode == 0) xcd_local_barrier(cnt, 32u, tmo);
        else if (mode == 1) xcd_barrier(bar);
        else { publish_count(cnt); wait_count(cnt, need, tmo); }
        float r4[2][4]; row_scales(ssq4, inv_w, row0, r4);
        f32x4 gv[2][2];
#pragma unroll
        for (int bj = 0; bj < 2; ++bj)
#pragma unroll
            for (int n = 0; n < 2; ++n) gv[bj][n] = *(const f32x4*)(gfin + col0 + bj * HALF + n * 16);
#pragma unroll
        for (int ai = 0; ai < 2; ++ai)
#pragma unroll
            for (int m = 0; m < 4; ++m) { float* yr = y + (size_t)(row0 + ai * HALF + m * 16) * DM + col0; const float r = r4[ai][m];
#pragma unroll
                for (int bj = 0; bj < 2; ++bj)
#pragma unroll
                    for (int n = 0; n < 2; ++n) __builtin_nontemporal_store(acc[ai][bj][m][n] * r * gv[bj][n], (f32x4*)(yr + bj * HALF + n * 16)); }
    }
};

struct Args { const float* in[25]; float* out; unsigned char* ws; int ph_lo, ph_hi; };
__global__ void __launch_bounds__(NWAVES * 64, 2) hymba_fwd(Args args) {
    extern __shared__ __attribute__((aligned(16))) unsigned char lds[];
    Frame F;
    F.lds = (LAS unsigned char*)lds;
    F.MISC = (volatile LAS unsigned*)(F.lds + MISC_OFF);
    F.tid = threadIdx.x; F.lane = F.tid & 63; F.wave = __builtin_amdgcn_readfirstlane(F.tid >> 6);
    F.G = gridDim.x; { const int bx = blockIdx.x; F.vcu = (F.G % 8 == 0) ? (bx % 8) * (F.G / 8) + bx / 8 : bx; }
    unsigned char* ws = args.ws;
    F.ctl = (unsigned*)(ws + WS_CTL); F.ws = ws;
#pragma unroll
    for (int i = 0; i < 25; ++i) F.in[i] = args.in[i];
    F.out = args.out;
    F.W1C = (bf16*)(ws + WS_W1C); F.W1D = (bf16*)(ws + WS_W1D); F.WIN = (bf16*)(ws + WS_WIN); F.WOUT = (bf16*)(ws + WS_WOUT); F.W2C = (bf16*)(ws + WS_W2C); F.W2D = (bf16*)(ws + WS_W2D);
    F.WPG = (bf16*)(ws + WS_WPG); F.WPP = (bf16*)(ws + WS_WPP); F.WPOOL = (bf16*)(ws + WS_WPOOL);
    F.HB = (bf16*)(ws + WS_HB); F.GB = (bf16*)(ws + WS_G); F.QB = (bf16*)(ws + WS_QB); F.KB = (bf16*)(ws + WS_KB); F.VB = (bf16*)(ws + WS_VB); F.PLB = (bf16*)(ws + WS_PLB);
    F.CB = (bf16*)(ws + WS_C); F.PROJ = (bf16*)(ws + WS_PROJ); F.PB = (bf16*)(ws + WS_PB); F.XP = (bf16*)(ws + WS_XP);
    { float* sq = (float*)(F.ctl + CW_SSQ); F.ssq0 = sq; F.ssq1 = sq + SSQ_STRIDE; F.ssqA = sq + 2 * SSQ_STRIDE; F.ssqP = sq + 3 * SSQ_STRIDE; F.ssq2 = sq + 4 * SSQ_STRIDE; F.ssq3 = sq + 5 * SSQ_STRIDE; F.ssq4 = sq + 6 * SSQ_STRIDE; }
    for (int u = F.tid; u < (LDS_BYTES - LDSCTL_OFF) / 4; u += NWAVES * 64) ((LAS unsigned*)(F.lds + LDSCTL_OFF))[u] = 0u;
    __syncthreads();
    const unsigned xcc = xb_xcc_id();
    if (F.tid == 0) F.MISC[20] = __hip_atomic_fetch_add(F.ctl + CW_RANK + 64 * xcc, 1u, __ATOMIC_RELAXED, __HIP_MEMORY_SCOPE_AGENT);
    XcdBarrier bar; bar.bar = (unsigned*)(F.ctl + CW_BAR); bar.x = 0; bar.st = nullptr;
    if (N_LAUNCHES != PER_PHASE) bar = xcd_barrier_post((unsigned*)(F.ctl + CW_BAR), F.MISC + 8);
#define GRID_BAR() do { if (N_LAUNCHES != PER_PHASE) xcd_barrier(bar); } while (0)
    const int lo = args.ph_lo, hi = args.ph_hi;
#define IN(k) (lo <= (k) && (k) < hi)
#define BOTH(k) (IN(k) && IN((k) + 1))
    float* const H = F.out + OFF_Y;
    const float inv_d = 1.0f / DM, inv_s = 1.0f / SBW;
    const int gw = F.vcu * NWAVES + F.wave, NGW = F.G * NWAVES;

    if (IN(0)) { p0_prologue(F); if (BOTH(0)) GRID_BAR(); }
    bool local_ok = false; int cdyn = (int)blockIdx.x;
    if (N_LAUNCHES != PER_PHASE && !FORCE_GRID_SEAMS) {
        if (F.tid == 0) { unsigned good = (F.G == 256) ? 1u : 0u;
#pragma unroll
            for (int q = 0; q < 16; ++q) { const unsigned c_ = __hip_atomic_load(F.ctl + CW_RANK + 64 * q, __ATOMIC_RELAXED, __HIP_MEMORY_SCOPE_AGENT); if (c_ != (q < 8 ? 32u : 0u)) good = 0u; }
            F.MISC[21] = good; }
        __syncthreads();
        local_ok = F.MISC[21] != 0u;
        if (local_ok) cdyn = (int)F.MISC[20] * 8 + (int)xcc;
    }
    unsigned* const lcnt = F.ctl + CW_RANK + 1024 + 64 * (local_ok ? xcc : 0u);
#define SEAM() do { if (N_LAUNCHES != PER_PHASE) { if (local_ok) xcd_local_barrier(lcnt, 32u, F.ctl + CW_CNT + 512); else xcd_barrier(bar); } } while (0)

    const int xg = cdyn % 8, jg = cdyn / 8;
    const int n1 = (xg < 4) ? 4 : 3;
    const bool s1_on = jg < n1 + 2; const int s1_pn = (xg < 4) ? xg * 6 + jg : 24 + (xg - 4) * 5 + jg;
    unsigned* const cnt = F.ctl + CW_CNT;
    unsigned* const tmo = F.ctl + CW_CNT + 512;
#define GEMM_CALL(EPI, SCHED, g, S, E) pg8::gemm_phase<EPI, SCHED>(F.lds + RING_OFF, g, S, E)
#define PG8_COMMA(a, b) pg8::EpiRes<a, b>
    int one = 1, two = 2, zero = 0; asm volatile("" : "+s"(one), "+s"(two), "+s"(zero));

    if (IN(1)) {
        const pg8::Gemm g1{F.HB, F.W1C, M, NCAT, DM, DM, DM, 0}; const pg8::EpiSwiGLU E1{F.GB, F.ssq0, inv_d};
        pg8::SkewOrder K1; K1.init(MP, NCAT, DM, F.G, cdyn, 0, 4); K1.lo[0] = 2 + n1; K1.lo[1] = 1; K1.lo[2] = 1; K1.lo[3] = 1; K1.lo[4] = 2; K1.lo[5] = 0;
        { pg8::OneTile S{32, s1_pn, DM / 64, s1_on ? one : zero}; GEMM_CALL(pg8::EpiSwiGLU, pg8::OneTile, g1, S, E1); if (s1_on) publish_count(cnt + 0); }
        GEMM_CALL(pg8::EpiSwiGLU, pg8::SkewOrder, g1, K1, E1);
        if (jg == 0) { wait_count(cnt + 0, 44u, tmo);
            pg8::Gemm g{F.GB, F.W1D, M, DM, FF, FF, FF, 0}; pg8::OneTile S{32, xg, FF / 64, one};
            pg8::EpiRes<false, true> E{nullptr, nullptr, F.HB, F.HB, F.ssq1, nullptr, 0.f, 0.5f, nullptr, nullptr, 0.f, nullptr, nullptr, nullptr};
            GEMM_CALL(PG8_COMMA(false, true), pg8::OneTile, g, S, E); publish_count(cnt + 64); }
        if (jg < 2) { wait_count(cnt + 64, 8u, tmo);
            pg8::Gemm g{F.HB, F.WIN, M, NIN, DM, DM, DM, 0}; pg8::OneTile S{32, jg * 8 + xg, DM / 64, one};
            pg8::EpiIn E{F.ssq1, inv_d, F.QB, F.KB, F.VB, F.XP, F.out}; GEMM_CALL(pg8::EpiIn, pg8::OneTile, g, S, E); }
        K1.r0 = 4; K1.r1 = 6; GEMM_CALL(pg8::EpiSwiGLU, pg8::SkewOrder, g1, K1, E1);
        { pg8::Gemm g{F.PB, F.WPP, M, DM, PLE, PLE, PLE, 0}; pg8::OneTile S{32, xg, PLE / 64, jg == 31 ? one : zero};
          pg8::EpiBf E{F.PROJ, DM, 0, nullptr}; GEMM_CALL(pg8::EpiBf, pg8::OneTile, g, S, E); }
        if (BOTH(1)) SEAM();
    }
    if (IN(2)) {
        pg8::Gemm g{F.GB, F.W1D, M, DM, FF, FF, FF, 0}; pg8::StaticOrder S; S.init(MP, DM, FF, F.G, cdyn);
        pg8::EpiRes<false, true> E{nullptr, nullptr, F.HB, F.HB, F.ssq1, nullptr, 0.f, 0.5f, nullptr, nullptr, 0.f, nullptr, nullptr, nullptr};
        GEMM_CALL(PG8_COMMA(false, true), pg8::StaticOrder, g, S, E);
        if (BOTH(2)) SEAM();
    }
    if (IN(3)) {
        pg8::Gemm g{F.HB, F.WIN, M, NIN, DM, DM, DM, 0}; pg8::StaticOrder S; S.init(MP, NIN, DM, F.G, cdyn);
        pg8::EpiIn E{F.ssq1, inv_d, F.QB, F.KB, F.VB, F.XP, F.out}; GEMM_CALL(pg8::EpiIn, pg8::StaticOrder, g, S, E);
        if (BOTH(3)) GRID_BAR();
    }
    if (IN(4)) {
        LAS unsigned char* vl = F.lds + RING_OFF + F.wave * VIMG_BYTES;
        constexpr int NU_S = DECB * NH, NU_P = BATCH * NH * (SEQ / 32);
        { const bool is_s = (F.wave == 0 && F.vcu < NU_S);
          const int nsb = (F.vcu < NU_S ? F.vcu : NU_S) + ((F.wave > 0 && F.vcu < NU_S) ? 1 : 0);
          const int idx = gw - nsb;
          if (is_s) sb_unit<true>(F, F.vcu / NH, F.vcu % NH, 0, vl);
          else {
              { const int k = idx, qblk = (SEQ / 32 - 1) - k / (BATCH * NH), bh = k % (BATCH * NH); sb_unit<false>(F, bh / NH, bh % NH, qblk, vl); }
              if (F.vcu >= 196 && F.vcu < 204) { const int k = (NGW - NU_S) + (F.vcu - 196) * NWAVES + F.wave, qblk = (SEQ / 32 - 1) - k / (BATCH * NH), bh = k % (BATCH * NH); sb_unit<false>(F, bh / NH, bh % NH, qblk, vl); }
          } }
        const int pb = F.vcu - 64;
        if (pb >= 0 && pb < 132) {
            const bool smp = pb >= 128; const int pm = smp ? 32 : (pb >> 2), g = smp ? pb - 128 : (pb & 3);
            if (smp) pool_unit(F, 512 + F.wave * 4 + g);
            else if (F.wave < 4) pool_unit(F, ((pm >> 3) << 7) | (g << 5) | ((pm & 7) * 4 + F.wave));
            VM_WAIT(); __syncthreads();
            if (F.tid == 0) { __builtin_amdgcn_fence(__ATOMIC_ACQUIRE, "agent"); VM_WAIT(); }
            __syncthreads();
            pg8::Gemm g5{F.PLB, F.WPOOL, M, PWID, 256, PWID, 256, 256}; pg8::EpiBf E5{F.CB, DM, SBW, F.ssqP};
            pg8::OneTile S{pm, g, 256 / 64, one}; GEMM_CALL(pg8::EpiBf, pg8::OneTile, g5, S, E5);
        }
        if (BOTH(4)) GRID_BAR();
    }
    if (IN(6)) {
        pg8::Gemm g{F.CB, F.WOUT, M, DM, DM, DM, DM, 0}; pg8::HalvesOrder S; S.init(MP, DM, DM, F.G, cdyn);
        pg8::EpiRes<true, true> E{nullptr, nullptr, F.HB, F.HB, F.ssq2, F.ssqP, inv_s, 1.0f, F.ssqA, F.ssqP, inv_s, nullptr, nullptr, nullptr};
        GEMM_CALL(PG8_COMMA(true, true), pg8::HalvesOrder, g, S, E);
        if (BOTH(6)) SEAM();
    }
    if (IN(7)) {
        const pg8::Gemm g5{F.HB, F.W2C, M, NCAT, DM, DM, DM, 0}; const pg8::EpiSwiGLU E5{F.GB, F.ssq2, inv_d};
        pg8::SkewOrder K5; K5.init(MP, NCAT, DM, F.G, cdyn, 0, 1); K5.lo[0] = 1; K5.lo[1] = n1 + 2; K5.lo[2] = 1; K5.lo[3] = 1; K5.lo[4] = 1; K5.lo[5] = 1; K5.hi[0] = 31; K5.hi[2] = 31; K5.hi[3] = 31;
        if (jg == 31) { pg8::Gemm g{F.CB, F.WOUT, M, DM, DM, DM, DM, 0}; pg8::OnePiece S{32, xg, 16, 16, one}; pg8::EpiRaw E{(float*)(ws + WS_SLAB + 2 * MiB)};
            GEMM_CALL(pg8::EpiRaw, pg8::OnePiece, g, S, E); publish_count(cnt + 1536 + 64 * xg); }
        if (jg == 0) { pg8::Gemm g{F.CB, F.WOUT, M, DM, DM, DM, DM, 0}; pg8::OnePiece S{32, xg, zero, 16, one};
            pg8::EpiRes<false, true, true, true> E{nullptr, nullptr, F.HB, F.HB, F.ssq2, F.ssqP, inv_s, 1.0f, F.ssqA, F.ssqP, inv_s, (const float*)(ws + WS_SLAB + 2 * MiB), cnt + 1536 + 64 * xg, tmo};
            pg8::gemm_phase<pg8::EpiRes<false, true, true, true>, pg8::OnePiece>(F.lds + RING_OFF, g, S, E); publish_count(cnt + 128); }
        GEMM_CALL(pg8::EpiSwiGLU, pg8::SkewOrder, g5, K5, E5);
        if (s1_on) { wait_count(cnt + 128, 8u, tmo); pg8::OneTile S{32, s1_pn, DM / 64, one}; GEMM_CALL(pg8::EpiSwiGLU, pg8::OneTile, g5, S, E5); publish_count(cnt + 192); }
        K5.r0 = 1; K5.r1 = 2; GEMM_CALL(pg8::EpiSwiGLU, pg8::SkewOrder, g5, K5, E5);
        if (jg == 31) { wait_count(cnt + 192, 44u, tmo);
            pg8::Gemm g{F.GB, F.W2D, M, DM, FF, FF, FF, 0}; pg8::OnePiece S{32, xg, 44, 44, one}; pg8::EpiRaw E{(float*)(ws + WS_SLAB)};
            GEMM_CALL(pg8::EpiRaw, pg8::OnePiece, g, S, E); publish_count(cnt + 1024 + 64 * xg); }
        if (jg == 0) { wait_count(cnt + 192, 44u, tmo);
            pg8::Gemm g{F.GB, F.W2D, M, DM, FF, FF, FF, 0}; pg8::OnePiece S{32, xg, zero, 44, one};
            pg8::EpiRes<false, true, true> E{nullptr, nullptr, F.HB, F.HB, F.ssq3, nullptr, 0.f, 0.5f, nullptr, nullptr, 0.f, (const float*)(ws + WS_SLAB), cnt + 1024 + 64 * xg, tmo};
            pg8::gemm_phase<pg8::EpiRes<false, true, true>, pg8::OnePiece>(F.lds + RING_OFF, g, S, E); publish_count(cnt + 256); }
        if (jg == 0) { wait_count(cnt + 256, 8u, tmo);
            pg8::Gemm g{F.HB, F.WPG, M, DM, DM, DM, DM, 0}; pg8::OneTile S{32, xg, DM / 64, one};
            EpiPleFinal E{H, F.HB, F.PROJ, F.ssq3, inv_d, F.ssq4, F.in[I_GFINAL], 2, cnt + 320, 8u, tmo, bar}; GEMM_CALL(EpiPleFinal, pg8::OneTile, g, S, E); }
        K5.r0 = 2; K5.r1 = 6; GEMM_CALL(pg8::EpiSwiGLU, pg8::SkewOrder, g5, K5, E5);
        if (BOTH(7)) SEAM();
    }
    if (IN(8)) {
        pg8::Gemm g{F.GB, F.W2D, M, DM, FF, FF, FF, 0}; pg8::StaticOrder S; S.init(MP, DM, FF, F.G, cdyn);
        pg8::EpiRes<false, true> E{nullptr, nullptr, F.HB, F.HB, F.ssq3, nullptr, 0.f, 0.5f, nullptr, nullptr, 0.f, nullptr, nullptr, nullptr};
        GEMM_CALL(PG8_COMMA(false, true), pg8::StaticOrder, g, S, E);
        if (BOTH(8)) SEAM();
    }
    if (IN(9)) {
        { pg8::Gemm gp{F.PB, F.WPP, M, DM, PLE, PLE, PLE, 0}; pg8::StaticOrder Sp; Sp.init(MP, DM, PLE, F.G, cdyn);
          pg8::EpiBf Ep{F.PROJ, DM, 0, nullptr}; GEMM_CALL(pg8::EpiBf, pg8::StaticOrder, gp, Sp, Ep); }
        pg8::Gemm g{F.HB, F.WPG, M, DM, DM, DM, DM, 0}; pg8::StaticOrder S; S.init(MP, DM, DM, F.G, cdyn);
        EpiPleFinal E{H, F.HB, F.PROJ, F.ssq3, inv_d, F.ssq4, F.in[I_GFINAL], local_ok ? 0 : 1, lcnt, 32u, tmo, bar}; GEMM_CALL(EpiPleFinal, pg8::StaticOrder, g, S, E);
    }
#undef IN
#undef BOTH
}

extern "C" void kernel_launch(void* const* d_in, const int* in_sizes, int n_in, void* d_out, int out_size, void* d_ws, size_t ws_size, hipStream_t stream) {
    static int grid = 0;
    if (grid == 0) {
        if (n_in != 25 || in_sizes[0] != MP * DM || (size_t)out_size != OUT_TOTAL || ws_size < WS_END) {
            fprintf(stderr, "kernel_launch: shape/workspace mismatch: n_in %d in0 %d out %d (want %zu) ws %zu (want %zu); nothing launched\n", n_in, n_in > 0 ? in_sizes[0] : -1, out_size, (size_t)OUT_TOTAL, ws_size, (size_t)WS_END); grid = -1; return; }
        int dev = 0, cus = 0, per_cu = 0;
        if (hipGetDevice(&dev) != hipSuccess || hipDeviceGetAttribute(&cus, hipDeviceAttributeMultiprocessorCount, dev) != hipSuccess) { fprintf(stderr, "kernel_launch: device query failed\n"); grid = -1; return; }
        if (hipFuncSetAttribute((const void*)hymba_fwd, hipFuncAttributeMaxDynamicSharedMemorySize, LDS_BYTES) != hipSuccess) { fprintf(stderr, "kernel_launch: hipFuncSetAttribute failed\n"); grid = -1; return; }
        if (hipOccupancyMaxActiveBlocksPerMultiprocessor(&per_cu, (const void*)hymba_fwd, NWAVES * 64, LDS_BYTES) != hipSuccess || per_cu < 1) { fprintf(stderr, "kernel_launch: occupancy query reports %d blocks per CU; nothing launched\n", per_cu); (void)hipGetLastError(); grid = -1; return; }
        if (cus != 256) { fprintf(stderr, "kernel_launch: the phase program deals tiles over 8 groups x 32 workgroups; this device has %d CUs; nothing launched\n", cus); grid = -1; return; }
        grid = cus;
    }
    if (grid < 0) return;
    if (hipMemsetAsync((char*)d_ws + WS_CTL, 0, CTL_ZERO_BYTES, stream) != hipSuccess) { fprintf(stderr, "kernel_launch: memset failed\n"); return; }
    Args a{};
    for (int i = 0; i < 25; ++i) a.in[i] = (const float*)d_in[i];
    a.out = (float*)d_out; a.ws = (unsigned char*)d_ws;
    if (N_LAUNCHES == 1) {
        a.ph_lo = 0; a.ph_hi = PER_PHASE;
        void* kargs[] = {&a};
        const hipError_t e = hipLaunchCooperativeKernel((const void*)hymba_fwd, dim3(grid), dim3(NWAVES * 64), kargs, LDS_BYTES, stream);
        if (e != hipSuccess) fprintf(stderr, "kernel_launch: cooperative launch failed: %s (grid %d)\n", hipGetErrorString(e), grid);
    } else {
        for (int li = 0; li < PER_PHASE; ++li) { a.ph_lo = li; a.ph_hi = li + 1;
            hipLaunchKernelGGL(hymba_fwd, dim3(grid), dim3(NWAVES * 64), LDS_BYTES, stream, a);
            const hipError_t le = hipPeekAtLastError(); if (le != hipSuccess) { fprintf(stderr, "kernel_launch: launch %d failed: %s\n", li, hipGetErrorName(le)); break; } }
    }
}
```

```cpp
#include <hip/hip_runtime.h>
#include <cstdio>
#include <cstdint>

#ifndef MK_N_LAUNCHES
#define MK_N_LAUNCHES 1
#endif
#ifndef FORCE_GRID_SEAMS
#define FORCE_GRID_SEAMS 0
#endif

constexpr int DM = 2048, FF = 5632, NCAT = 2 * FF, NIN = 4096, SBW = 1024, PWID = 1024, PLE = 256;
constexpr int BATCH = 4, SEQ = 2048, DECB = 8, DECS = 32, PAST = 2048, NH = 8, HD = 128, PSTATE = 15;
constexpr int MP = BATCH * SEQ, MS = DECB * DECS, M = MP + MS;
constexpr float RMS_EPS = 1e-6f;
constexpr float LOG2E = 1.4426950408889634f;
constexpr float QSCALE = 0.08838834764831845f * LOG2E;
constexpr size_t OFF_Y = 0;
constexpr size_t OFF_KP = (size_t)M * DM;
constexpr size_t OFF_VP = OFF_KP + (size_t)MP * SBW;
constexpr size_t OFF_PP = OFF_VP + (size_t)MP * SBW;
constexpr size_t OFF_KS = OFF_PP + (size_t)BATCH * PSTATE * PWID;
constexpr size_t OFF_VS = OFF_KS + (size_t)MS * SBW;
constexpr size_t OFF_PS = OFF_VS + (size_t)MS * SBW;
constexpr size_t OUT_TOTAL = OFF_PS + (size_t)DECB * PSTATE * PWID;

namespace pg8 {
#define PG8_LAS __attribute__((address_space(3)))
typedef unsigned short bf16_t;
typedef short bf16x8 __attribute__((ext_vector_type(8)));
typedef float f32x4 __attribute__((ext_vector_type(4)));
typedef unsigned u32x4 __attribute__((ext_vector_type(4)));
typedef unsigned u32x2 __attribute__((ext_vector_type(2)));
constexpr int BM = 256, BK = 64, HALF = 128, HTB = HALF * BK * 2, STAGE_BYTES = 8 * HTB, NXCD = 8, WGM = 4;

__host__ __device__ __forceinline__ int lds_byte(int r, int c) { const int st = (r >> 4) * 2 + (c >> 5), rr = r & 15, cc = c & 31, ob = rr * 64 + cc * 2; return st * 1024 + (ob ^ (((ob >> 9) & 1) << 5)); }
__host__ __device__ __forceinline__ void stage_rc(int b, int& R, int& C) { const int st = b / 1024, sb = b % 1024, swz = sb ^ (((sb >> 9) & 1) << 5); R = (st >> 1) * 16 + swz / 64; C = (st & 1) * 32 + (swz % 64) / 2; }

struct Unit { int pm, pn, kt0, nkt, part; };
struct Gemm { const bf16_t* A; const bf16_t* Bt; int M, N, K, lda, ldb, a_pn_off; };

__host__ __device__ __forceinline__ void tile_of(int wgid_in, int nwg, int nM, int nN, int& pm, int& pn) {
    int wgid = wgid_in; { const int q = nwg / NXCD, r = nwg % NXCD, xcd = wgid % NXCD, off = wgid / NXCD; wgid = (xcd < r ? xcd * (q + 1) : r * (q + 1) + (xcd - r) * q) + off; }
    const int nig = WGM * nN, gid = wgid / nig, fm = gid * WGM, gsz = (nM - fm) < WGM ? (nM - fm) : WGM;
    pm = fm + ((wgid % nig) % gsz); pn = (wgid % nig) / gsz;
}
struct StaticOrder {
    int nM, nN, nwg, G, c, NT;
    __host__ __device__ __forceinline__ void init(int M, int N, int K, int G_, int c_) { nM = M / BM; nN = N / BM; nwg = nM * nN; G = G_; c = c_; NT = K / BK; }
    __host__ __device__ __forceinline__ bool next(int i, Unit& u) const {
        const long L = (long)i * G + c; const bool ok = L < nwg; int pm = 0, pn = 0;
        if (ok) tile_of((int)L, nwg, nM, nN, pm, pn);
        u.pm = pm; u.pn = pn; u.kt0 = 0; u.nkt = NT; u.part = 0; return ok;
    }
    __device__ __forceinline__ void a_ready(const Unit&) const {}
    __device__ __forceinline__ void done(const Unit&) const {}
};
struct HalvesOrder {
    int nM, nN, nwg, G, c, NT;
    __host__ __device__ __forceinline__ void init(int M, int N, int K, int G_, int c_) { nM = M / BM; nN = N / BM; nwg = nM * nN; G = G_; c = c_; NT = K / BK; }
    __host__ __device__ __forceinline__ bool next(int i, Unit& u) const {
        const long L = (long)(i >> 1) * G + c; const bool ok = L < nwg; int pm = 0, pn = 0;
        if (ok) tile_of((int)L, nwg, nM, nN, pm, pn);
        const int nkt = NT >> 1;
        u.pm = pm; u.pn = pn; u.kt0 = (i & 1) * nkt; u.nkt = nkt; u.part = (i & 1) ? 0 : 2; return ok;
    }
    __device__ __forceinline__ void a_ready(const Unit&) const {}
    __device__ __forceinline__ void done(const Unit&) const {}
};
template <bool HALVES> struct OneTileT {
    int pm, pn, NT, on;
    __host__ __device__ __forceinline__ bool next(int i, Unit& u) const {
        const int nkt = HALVES ? (NT >> 1) : NT;
        u.pm = pm; u.pn = pn; u.kt0 = HALVES ? (i & 1) * nkt : 0; u.nkt = nkt; u.part = HALVES ? ((i & 1) ? 0 : 2) : 0;
        return on > i * (HALVES ? 1 : 2);
    }
    __device__ __forceinline__ void a_ready(const Unit&) const {}
    __device__ __forceinline__ void done(const Unit&) const {}
};
typedef OneTileT<false> OneTile; typedef OneTileT<true> OneTileH;
struct OnePiece {
    int pm, pn, kt0, nkt, on;
    __host__ __device__ __forceinline__ bool next(int i, Unit& u) const { u.pm = pm; u.pn = pn; u.kt0 = kt0; u.nkt = nkt; u.part = 0; return on > i * 2; }
    __device__ __forceinline__ void a_ready(const Unit&) const {}
    __device__ __forceinline__ void done(const Unit&) const {}
};
struct SkewOrder {
    int nM, nN, nwg, chunk, x, j, r0, r1, NT; int lo[6], hi[6];
    __host__ __device__ __forceinline__ void init(int M, int N, int K, int G, int c, int r0_, int r1_) { nM = M / BM; nN = N / BM; nwg = nM * nN; chunk = nwg / NXCD; x = c % NXCD; j = c / NXCD; r0 = r0_; r1 = r1_; NT = K / BK; (void)G;
#pragma unroll
        for (int r = 0; r < 6; ++r) hi[r] = 32; }
    __host__ __device__ __forceinline__ bool next(int i, Unit& u) const {
        int pre = 0, k = 0, off = -1;
#pragma unroll
        for (int r = 0; r < 6; ++r) { const bool act = j >= lo[r] && j < hi[r]; if (act && r >= r0 && r < r1) { if (k == i) off = pre + (j - lo[r]); ++k; } pre += hi[r] - lo[r]; }
        const bool ok = off >= 0 && off < chunk; int pm = 0, pn = 0;
        if (ok) { const int wgid = x * chunk + off; const int nig = WGM * nN, gid = wgid / nig, fm = gid * WGM, gsz = (nM - fm) < WGM ? (nM - fm) : WGM; pm = fm + ((wgid % nig) % gsz); pn = (wgid % nig) / gsz; }
        u.pm = pm; u.pn = pn; u.kt0 = 0; u.nkt = NT; u.part = 0; return ok;
    }
    __device__ __forceinline__ void a_ready(const Unit&) const {}
    __device__ __forceinline__ void done(const Unit&) const {}
};
typedef float f32x2 __attribute__((ext_vector_type(2)));
typedef __bf16 bf16x2_t __attribute__((ext_vector_type(2)));
__device__ __forceinline__ unsigned pk2(float lo, float hi) { f32x2 v = {lo, hi}; bf16x2_t b = __builtin_convertvector(v, bf16x2_t); return __builtin_bit_cast(unsigned, b); }
__device__ __forceinline__ u32x2 pk4(f32x4 v) { u32x2 w; w.x = pk2(v[0], v[1]); w.y = pk2(v[2], v[3]); return w; }
__device__ __forceinline__ float bf_lo(unsigned w) { return __uint_as_float(w << 16); }
__device__ __forceinline__ float bf_hi(unsigned w) { return __uint_as_float(w & 0xffff0000u); }
__device__ __forceinline__ float rs_of(float ssq, float inv_w) { return __builtin_amdgcn_rsqf(ssq * inv_w + RMS_EPS); }
__device__ __forceinline__ float sigmoidf_(float g) { return __builtin_amdgcn_rcpf(1.0f + __builtin_amdgcn_exp2f(-g * LOG2E)); }
__device__ __forceinline__ float dot4(f32x4 v) { return (v[0] * v[0] + v[1] * v[1]) + (v[2] * v[2] + v[3] * v[3]); }

__device__ __forceinline__ void row_scales(const float* ssq, float inv_w, int row0, float (&rsv)[2][4]) {
    float q[2][4];
#pragma unroll
    for (int ai = 0; ai < 2; ++ai)
#pragma unroll
        for (int m = 0; m < 4; ++m) q[ai][m] = ssq[row0 + ai * HALF + m * 16];
#pragma unroll
    for (int ai = 0; ai < 2; ++ai)
#pragma unroll
        for (int m = 0; m < 4; ++m) rsv[ai][m] = rs_of(q[ai][m], inv_w);
}

struct AccSrc { const f32x4 (&acc)[2][2][4][2]; __device__ __forceinline__ f32x4 operator()(int ai, int bj, int m, int n) const { return acc[ai][bj][m][n]; } };
struct EpiSwiGLU {
    static constexpr bool AFTER_DRAIN = false, MID = false, FINAL = false;
    bf16_t* G; const float* ssq; float inv_w;
    template <class Src> __device__ __forceinline__ void run(const Src& src, const Unit& u, int wr, int wc, int fr, int fq) const {
        const int row0 = u.pm * BM + wr * 64 + fr, col0 = u.pn * HALF + wc * 32 + 4 * fq;
        float rsv[2][4]; row_scales(ssq, inv_w, row0, rsv);
#pragma unroll
        for (int ai = 0; ai < 2; ++ai)
#pragma unroll
            for (int m = 0; m < 4; ++m) { const int row = row0 + ai * HALF + m * 16; const float r = rsv[ai][m]; bf16_t* rowp = G + (size_t)row * FF + col0;
#pragma unroll
                for (int n = 0; n < 2; ++n) { const f32x4 g = src(ai, 0, m, n) * r, up = src(ai, 1, m, n) * r; f32x4 v;
#pragma unroll
                    for (int i = 0; i < 4; ++i) v[i] = g[i] * sigmoidf_(g[i]) * up[i];
                    *(u32x2*)(rowp + n * 16) = pk4(v); }
                if (m & 1) asm volatile("" ::: "memory"); }
    }
};
struct EpiBf {
    static constexpr bool AFTER_DRAIN = false, MID = false, FINAL = false;
    bf16_t* O; int ldc, col_base; float* ssq_out;
    template <class Src> __device__ __forceinline__ void run(const Src& src, const Unit& u, int wr, int wc, int fr, int fq) const {
        const int row0 = u.pm * BM + wr * 64 + fr, col0 = col_base + u.pn * BM + wc * 32 + 4 * fq;
#pragma unroll
        for (int ai = 0; ai < 2; ++ai)
#pragma unroll
            for (int m = 0; m < 4; ++m) { const int row = row0 + ai * HALF + m * 16; bf16_t* rowp = O + (size_t)row * ldc + col0; float s = 0.f;
#pragma unroll
                for (int bj = 0; bj < 2; ++bj)
#pragma unroll
                    for (int n = 0; n < 2; ++n) { const f32x4 v = src(ai, bj, m, n); *(u32x2*)(rowp + bj * HALF + n * 16) = pk4(v); s += dot4(v); }
                if (ssq_out) { s += __shfl_xor(s, 16); s += __shfl_xor(s, 32); if (fq == 0) atomicAdd(ssq_out + row, s); }
                if (m & 1) asm volatile("" ::: "memory"); }
    }
};
struct EpiRaw {
    static constexpr bool AFTER_DRAIN = false, MID = false, FINAL = false;
    float* slab;
    template <class Src> __device__ __forceinline__ void run(const Src& src, const Unit& u, int wr, int wc, int fr, int fq) const {
        float* t = slab + (size_t)u.pn * 65536 + (size_t)(wr * 64 + fr) * 256 + wc * 32 + 4 * fq;
#pragma unroll
        for (int ai = 0; ai < 2; ++ai)
#pragma unroll
            for (int m = 0; m < 4; ++m)
#pragma unroll
                for (int bj = 0; bj < 2; ++bj)
#pragma unroll
                    for (int n = 0; n < 2; ++n) *(f32x4*)(t + (ai * HALF + m * 16) * 256 + bj * HALF + n * 16) = src(ai, bj, m, n);
    }
};
template <bool HAS_MID, bool BASE_BF16, bool ADD_SLAB = false, bool PRE_SCALE = false> struct EpiRes {
    static constexpr bool AFTER_DRAIN = false, MID = HAS_MID, FINAL = false;
    const float* base0; const float* base1;
    const bf16_t* baseb; bf16_t* outb; float* ssq_out;
    const float* ssq_rs; float inv_w_rs, alpha;
    const float* ssq_a; const float* ssq_p; float inv_w_mid;
    const float* slab; unsigned* flag; unsigned* tmo;
    __device__ __forceinline__ float midf(int row) const { return __builtin_amdgcn_sqrtf((ssq_p[row] * inv_w_mid + RMS_EPS) * __builtin_amdgcn_rcpf(ssq_a[row] * inv_w_mid + RMS_EPS)); }
    __device__ __forceinline__ void mid(f32x4 (&acc)[2][2][4][2], const Unit& u, int wr, int wc, int fr, int fq) const {
        const int row0 = u.pm * BM + wr * 64 + fr;
        float qa[2][4], qp[2][4];
#pragma unroll
        for (int ai = 0; ai < 2; ++ai)
#pragma unroll
            for (int m = 0; m < 4; ++m) { const int row = row0 + ai * HALF + m * 16; qa[ai][m] = ssq_a[row]; qp[ai][m] = ssq_p[row]; }
#pragma unroll
        for (int ai = 0; ai < 2; ++ai)
#pragma unroll
            for (int m = 0; m < 4; ++m) { const float f = __builtin_amdgcn_sqrtf((qp[ai][m] * inv_w_mid + RMS_EPS) * __builtin_amdgcn_rcpf(qa[ai][m] * inv_w_mid + RMS_EPS));
#pragma unroll
                for (int bj = 0; bj < 2; ++bj)
#pragma unroll
                    for (int n = 0; n < 2; ++n) acc[ai][bj][m][n] *= f; }
    }
    template <class Src> __device__ __forceinline__ void run(const Src& src, const Unit& u, int wr, int wc, int fr, int fq) const {
        const int row0 = u.pm * BM + wr * 64 + fr, col0 = u.pn * BM + wc * 32 + 4 * fq;
        const float* base = (u.pm * BM < MP) ? base0 : base1;
        const float* pt = nullptr;
        float scv[2][4];
        if (ssq_rs) { row_scales(ssq_rs, inv_w_rs, row0, scv);
#pragma unroll
            for (int ai = 0; ai < 2; ++ai)
#pragma unroll
                for (int m = 0; m < 4; ++m) scv[ai][m] *= alpha; }
        else {
#pragma unroll
            for (int ai = 0; ai < 2; ++ai)
#pragma unroll
                for (int m = 0; m < 4; ++m) scv[ai][m] = alpha; }
        if constexpr (ADD_SLAB) {
            if (threadIdx.x == 0) { unsigned sp = 0;
                while (__hip_atomic_load(flag, __ATOMIC_RELAXED, __HIP_MEMORY_SCOPE_AGENT) == 0u) { __builtin_amdgcn_s_sleep(8); if (++sp > (1u << 22)) { atomicAdd(tmo, 1u); break; } }
                __builtin_amdgcn_fence(__ATOMIC_ACQUIRE, "agent"); asm volatile("s_waitcnt vmcnt(0)" ::: "memory"); }
            asm volatile("" ::: "memory"); __builtin_amdgcn_s_barrier(); asm volatile("" ::: "memory");
            pt = slab + (size_t)u.pn * 65536 + (size_t)(wr * 64 + fr) * 256 + wc * 32 + 4 * fq; }
#pragma unroll
        for (int ai = 0; ai < 2; ++ai) {
            u32x2 bw[4][2][2];
            if constexpr (BASE_BF16) {
#pragma unroll
                for (int m = 0; m < 4; ++m)
#pragma unroll
                    for (int bj = 0; bj < 2; ++bj)
#pragma unroll
                        for (int n = 0; n < 2; ++n) bw[m][bj][n] = *(const u32x2*)(baseb + (size_t)(row0 + ai * HALF + m * 16) * DM + col0 + bj * HALF + n * 16); }
#pragma unroll
            for (int m = 0; m < 4; ++m) { const int row = row0 + ai * HALF + m * 16; const size_t off = (size_t)row * DM + col0;
                const float sc = scv[ai][m]; float s = 0.f; float pre = 1.0f; if constexpr (PRE_SCALE) pre = midf(row);
                f32x4 sl[2][2];
                if constexpr (ADD_SLAB) {
#pragma unroll
                    for (int bj = 0; bj < 2; ++bj)
#pragma unroll
                        for (int n = 0; n < 2; ++n) sl[bj][n] = *(const f32x4*)(pt + (ai * HALF + m * 16) * 256 + bj * HALF + n * 16); }
#pragma unroll
                for (int bj = 0; bj < 2; ++bj)
#pragma unroll
                    for (int n = 0; n < 2; ++n) { const int co = bj * HALF + n * 16; f32x4 b;
                        if constexpr (BASE_BF16) { const u32x2 w = bw[m][bj][n]; b = (f32x4){bf_lo(w.x), bf_hi(w.x), bf_lo(w.y), bf_hi(w.y)}; }
                        else b = *(const f32x4*)(base + off + co);
                        f32x4 a4 = src(ai, bj, m, n); if constexpr (PRE_SCALE) a4 *= pre; if constexpr (ADD_SLAB) a4 += sl[bj][n];
                        const f32x4 v = b + a4 * sc;
                        *(u32x2*)(outb + off + co) = pk4(v); s += dot4(v); }
                s += __shfl_xor(s, 16); s += __shfl_xor(s, 32); if (fq == 0) atomicAdd(ssq_out + row, s);
                if (m & 1) asm volatile("" ::: "memory"); }
        }
    }
};
struct EpiIn {
    static constexpr bool AFTER_DRAIN = false, MID = false, FINAL = false;
    const float* ssq; float inv_w; bf16_t *qb, *kb, *vb, *xp; float* out;
    template <class Src> __device__ __forceinline__ void run(const Src& src, const Unit& u, int wr, int wc, int fr, int fq) const {
        const int row0 = u.pm * BM + wr * 64 + fr, seg = u.pn >> 2, cseg = (u.pn & 3) * BM + wc * 32 + 4 * fq;
        const bool prompt = u.pm * BM < MP;
        float rsv[2][4]; row_scales(ssq, inv_w, row0, rsv);
#pragma unroll
        for (int ai = 0; ai < 2; ++ai)
#pragma unroll
            for (int m = 0; m < 4; ++m) { const int row = row0 + ai * HALF + m * 16; const float r = rsv[ai][m]; const size_t off = (size_t)row * SBW + cseg;
                float* fo = nullptr; float* po = nullptr;
                if (seg == 1) fo = prompt ? out + OFF_KP + off : out + OFF_KS + ((size_t)(row - MP) * SBW + cseg);
                if (seg == 2) fo = prompt ? out + OFF_VP + off : out + OFF_VS + ((size_t)(row - MP) * SBW + cseg);
                if (seg == 3) { if (prompt) { const int b = row / SEQ, t = row % SEQ; if (t >= SEQ - PSTATE) po = out + OFF_PP + ((size_t)(b * PSTATE + t - (SEQ - PSTATE)) * PWID + cseg); }
                                else { const int rs_ = row - MP, b = rs_ / DECS, t = rs_ % DECS; if (t >= DECS - PSTATE) po = out + OFF_PS + ((size_t)(b * PSTATE + t - (DECS - PSTATE)) * PWID + cseg); } }
#pragma unroll
                for (int bj = 0; bj < 2; ++bj)
#pragma unroll
                    for (int n = 0; n < 2; ++n) { const int co = bj * HALF + n * 16; const f32x4 v = src(ai, bj, m, n) * r;
                        if (seg == 0) *(u32x2*)(qb + off + co) = pk4(v * QSCALE);
                        else if (seg == 1) { *(u32x2*)(kb + off + co) = pk4(v); __builtin_nontemporal_store(v, (f32x4*)(fo + co)); }
                        else if (seg == 2) { *(u32x2*)(vb + off + co) = pk4(v); __builtin_nontemporal_store(v, (f32x4*)(fo + co)); }
                        else { *(u32x2*)(xp + off + co) = pk4(v); if (po) *(f32x4*)(po + co) = v; } }
                if (m & 1) asm volatile("" ::: "memory"); }
    }
};
struct EpiPle {
    static constexpr bool AFTER_DRAIN = false, MID = false, FINAL = false;
    bf16_t* h; const bf16_t* hb; const bf16_t* proj; const float* ssq; float inv_w; float* ssq_out;
    template <class Src> __device__ __forceinline__ void run(const Src& src, const Unit& u, int wr, int wc, int fr, int fq) const {
        const int row0 = u.pm * BM + wr * 64 + fr, col0 = u.pn * BM + wc * 32 + 4 * fq;
        float rsv[2][4]; row_scales(ssq, inv_w, row0, rsv);
#pragma unroll
        for (int ai = 0; ai < 2; ++ai) {
            u32x2 hw[4][2][2], pj[4][2][2];
#pragma unroll
            for (int m = 0; m < 4; ++m)
#pragma unroll
                for (int bj = 0; bj < 2; ++bj)
#pragma unroll
                    for (int n = 0; n < 2; ++n) { const size_t o = (size_t)(row0 + ai * HALF + m * 16) * DM + col0 + bj * HALF + n * 16; hw[m][bj][n] = *(const u32x2*)(hb + o); pj[m][bj][n] = *(const u32x2*)(proj + o); }
#pragma unroll
            for (int m = 0; m < 4; ++m) { const int row = row0 + ai * HALF + m * 16; const size_t off = (size_t)row * DM + col0; const float r = rsv[ai][m]; float s = 0.f;
#pragma unroll
                for (int bj = 0; bj < 2; ++bj)
#pragma unroll
                    for (int n = 0; n < 2; ++n) { const int co = bj * HALF + n * 16; const u32x2 w = hw[m][bj][n], p = pj[m][bj][n]; const f32x4 b = (f32x4){bf_lo(w.x), bf_hi(w.x), bf_lo(w.y), bf_hi(w.y)};
                        const f32x4 g = src(ai, bj, m, n) * r; f32x4 v;
                        v[0] = b[0] + sigmoidf_(g[0]) * bf_lo(p.x); v[1] = b[1] + sigmoidf_(g[1]) * bf_hi(p.x); v[2] = b[2] + sigmoidf_(g[2]) * bf_lo(p.y); v[3] = b[3] + sigmoidf_(g[3]) * bf_hi(p.y);
                        *(u32x2*)(h + off + co) = pk4(v); s += dot4(v); }
                s += __shfl_xor(s, 16); s += __shfl_xor(s, 32); if (fq == 0) atomicAdd(ssq_out + row, s);
                if (m & 1) asm volatile("" ::: "memory"); }
        }
    }
};

template <class Epi, class Sched, bool ALIGN_EPI = true>
__device__ __forceinline__ void gemm_phase(PG8_LAS unsigned char* lds, const Gemm g, const Sched& S, const Epi& E) {
    const int tid = threadIdx.x, wid = __builtin_amdgcn_readfirstlane(tid >> 6), lane = tid & 63, wr = wid >> 2, wc = wid & 3, fr = lane & 15, fq = lane >> 4;
    int K_ = g.K; asm volatile("" : "+s"(K_));
    const int K = K_, nt = K / BK;
    unsigned voffA[2], voffB[2];
#pragma unroll
    for (int i = 0; i < 2; ++i) { int R, C; stage_rc(tid * 16 + i * 8192, R, C); voffA[i] = (unsigned)(R * g.lda + C) * 2u; voffB[i] = (unsigned)(R * g.ldb + C) * 2u; }
    const size_t kstep = (size_t)(BK * 2);
    const size_t hstepA = (size_t)HALF * g.lda * 2, hstepB = (size_t)HALF * g.ldb * 2;
    const size_t tstepA = 2 * hstepA, tstepB = 2 * hstepB;
    const unsigned ldsw = (unsigned)wid * 1024u;
    const int aoff = lds_byte(wr * 64 + fr, fq * 8), boff = lds_byte(wc * 32 + fr, fq * 8);
#define PG8_SA(b, h) (((b) * 2 + (h)) * HTB)
#define PG8_SB(b, h) ((4 + (b) * 2 + (h)) * HTB)
#define PG8_STAGE(bufoff, gbase, voff) do { _Pragma("unroll") for (int _i = 0; _i < 2; ++_i) \
        __builtin_amdgcn_global_load_lds((const unsigned*)((const char*)(gbase) + (voff)[_i]), (PG8_LAS unsigned*)(lds + (bufoff) + ldsw + _i * 8192), 16, 0, 0); } while (0)
#define PG8_LDA(dst, b, h) do { _Pragma("unroll") for (int m = 0; m < 4; ++m) _Pragma("unroll") for (int k = 0; k < 2; ++k) dst[m][k] = *(const PG8_LAS bf16x8*)(lds + PG8_SA(b, h) + aoff + m * 2048 + k * 1024); } while (0)
#define PG8_LDB(dst, b, h) do { _Pragma("unroll") for (int n = 0; n < 2; ++n) _Pragma("unroll") for (int k = 0; k < 2; ++k) dst[n][k] = *(const PG8_LAS bf16x8*)(lds + PG8_SB(b, h) + boff + n * 2048 + k * 1024); } while (0)
#define PG8_MMA(ai, bj, At, Bt) do { __builtin_amdgcn_s_setprio(1); _Pragma("unroll") for (int m = 0; m < 4; ++m) _Pragma("unroll") for (int n = 0; n < 2; ++n) _Pragma("unroll") for (int k = 0; k < 2; ++k) \
        acc[ai][bj][m][n] = __builtin_amdgcn_mfma_f32_16x16x32_bf16(Bt[n][k], At[m][k], acc[ai][bj][m][n], 0, 0, 0); __builtin_amdgcn_s_setprio(0); } while (0)
#define PG8_WAIT_V(n) asm volatile("s_waitcnt vmcnt(" #n ")" ::: "memory")
#define PG8_WAIT_L(n) asm volatile("s_waitcnt lgkmcnt(" #n ")" ::: "memory")
#define PG8_BAR __builtin_amdgcn_s_barrier()
#define PG8_SCHED __builtin_amdgcn_sched_barrier(0)
    Unit cur, nxt; int ui = 0;
    if (!S.next(0, cur)) return;
    f32x4 acc[2][2][4][2];
#pragma unroll
    for (int a = 0; a < 2; ++a)
#pragma unroll
        for (int b = 0; b < 2; ++b)
#pragma unroll
            for (int m = 0; m < 4; ++m)
#pragma unroll
                for (int n = 0; n < 2; ++n) acc[a][b][m][n] = (f32x4){0.f, 0.f, 0.f, 0.f};
    bf16x8 At[4][2], B0[2][2], B1[2][2];
    const char* cA = (const char*)g.A + (size_t)cur.pm * tstepA + (size_t)cur.pn * g.a_pn_off * 2 + (size_t)cur.kt0 * kstep; const char* cB = (const char*)g.Bt + (size_t)cur.pn * tstepB + (size_t)cur.kt0 * kstep;
    S.a_ready(cur);
    PG8_STAGE(PG8_SB(0, 0), cB, voffB); PG8_STAGE(PG8_SB(0, 1), cB + hstepB, voffB); PG8_STAGE(PG8_SA(0, 0), cA, voffA); PG8_STAGE(PG8_SA(0, 1), cA + hstepA, voffA);
    if (wr == 1) PG8_BAR;
    PG8_WAIT_V(2); PG8_BAR;
    PG8_STAGE(PG8_SB(1, 0), cB + kstep, voffB); PG8_STAGE(PG8_SA(1, 0), cA + kstep, voffA); PG8_STAGE(PG8_SB(1, 1), cB + hstepB + kstep, voffB);
    PG8_WAIT_V(6); PG8_BAR;
    for (;;) {
        const bool has_next = S.next(ui + 1, nxt);
        const char* nA = has_next ? (const char*)g.A + (size_t)nxt.pm * tstepA + (size_t)nxt.pn * g.a_pn_off * 2 + (size_t)nxt.kt0 * kstep : cA; const char* nB = has_next ? (const char*)g.Bt + (size_t)nxt.pn * tstepB + (size_t)nxt.kt0 * kstep : cB;
        const int unt = cur.nkt;
        asm volatile(".p2align 8" ::: "memory");
        for (int t = 0; t < unt; t += 2) {
            const bool last = (t == unt - 2);
            const char* a1 = cA + (size_t)(t + 1) * kstep;
            const char* a2 = last ? nA : cA + (size_t)(t + 2) * kstep; const char* b2 = last ? nB : cB + (size_t)(t + 2) * kstep;
            const char* a3 = a2 + kstep; const char* b3 = b2 + kstep;
            if (last && has_next) S.a_ready(nxt);
            PG8_LDB(B0, 0, 0); PG8_LDB(B1, 0, 1); PG8_SCHED; PG8_LDA(At, 0, 0); PG8_STAGE(PG8_SA(1, 1), a1 + hstepA, voffA);
            PG8_WAIT_V(8); PG8_WAIT_L(0); PG8_BAR; PG8_MMA(0, 0, At, B0); PG8_MMA(0, 1, At, B1); PG8_BAR; PG8_SCHED;
            PG8_LDA(At, 0, 1); PG8_STAGE(PG8_SB(0, 0), b2, voffB); PG8_STAGE(PG8_SB(0, 1), b2 + hstepB, voffB); PG8_STAGE(PG8_SA(0, 0), a2, voffA);
            PG8_WAIT_V(8); PG8_WAIT_L(0); PG8_BAR; PG8_MMA(1, 0, At, B0); PG8_MMA(1, 1, At, B1); PG8_BAR; PG8_SCHED;
            PG8_LDB(B0, 1, 0); PG8_LDB(B1, 1, 1); PG8_SCHED; PG8_LDA(At, 1, 0); PG8_STAGE(PG8_SA(0, 1), a2 + hstepA, voffA);
            PG8_WAIT_V(8); PG8_WAIT_L(0); PG8_BAR; PG8_MMA(0, 0, At, B0); PG8_MMA(0, 1, At, B1); PG8_BAR; PG8_SCHED;
            PG8_LDA(At, 1, 1); PG8_STAGE(PG8_SB(1, 0), b3, voffB); PG8_STAGE(PG8_SB(1, 1), b3 + hstepB, voffB); PG8_STAGE(PG8_SA(1, 0), a3, voffA);
            PG8_WAIT_V(8); PG8_WAIT_L(0); PG8_BAR; PG8_MMA(1, 0, At, B0); PG8_MMA(1, 1, At, B1); PG8_BAR; PG8_SCHED;
        }
        if constexpr (ALIGN_EPI) { if (wr == 0) PG8_BAR; }
        bool carry = false;
        if constexpr (Epi::MID) carry = cur.part == 2;
        Unit eu = cur; asm volatile("" : "+s"(eu.pm), "+s"(eu.pn));
        if (carry) { if constexpr (Epi::MID) E.mid(acc, eu, wr, wc, fr, fq); }
        else if constexpr (Epi::FINAL) E.run_final(acc, eu, wr, wc, fr, fq);
        else E.run(AccSrc{acc}, eu, wr, wc, fr, fq);
        S.done(cur);
        if (!has_next) break;
        if (!carry) {
#pragma unroll
        for (int a = 0; a < 2; ++a)
#pragma unroll
            for (int b = 0; b < 2; ++b)
#pragma unroll
                for (int m = 0; m < 4; ++m)
#pragma unroll
                    for (int n = 0; n < 2; ++n) acc[a][b][m][n] = (f32x4){0.f, 0.f, 0.f, 0.f};
        }
        cur = nxt; cA = nA; cB = nB; ++ui;
        if constexpr (ALIGN_EPI) { if (wr == 1) PG8_BAR; }
    }
    PG8_WAIT_V(0);
    if constexpr (!ALIGN_EPI) { if (wr == 0) PG8_BAR; }
    PG8_BAR;
#undef PG8_SA
#undef PG8_SB
#undef PG8_STAGE
#undef PG8_LDA
#undef PG8_LDB
#undef PG8_MMA
#undef PG8_WAIT_V
#undef PG8_WAIT_L
#undef PG8_BAR
#undef PG8_SCHED
}
}

constexpr int NWAVES = 8;
constexpr int PER_PHASE = 11;
constexpr int N_LAUNCHES = MK_N_LAUNCHES;

#define GAS __attribute__((address_space(1)))
#define LAS __attribute__((address_space(3)))
typedef unsigned short bf16;
typedef unsigned v4u __attribute__((ext_vector_type(4)));
typedef unsigned v2u __attribute__((ext_vector_type(2)));
typedef float f32x4 __attribute__((ext_vector_type(4)));
typedef float f32x16 __attribute__((ext_vector_type(16)));
typedef short bf16x8 __attribute__((ext_vector_type(8)));
typedef short s16x4 __attribute__((ext_vector_type(4)));
typedef GAS unsigned gu32;
#define RLX_AGENT __ATOMIC_RELAXED, __HIP_MEMORY_SCOPE_AGENT
#define LDS_WAIT() asm volatile("s_waitcnt lgkmcnt(0)" ::: "memory")
#define VM_WAIT() asm volatile("s_waitcnt vmcnt(0)" ::: "memory")
using pg8::pk2; using pg8::pk4;

constexpr size_t MiB = 1u << 20;
constexpr size_t al(size_t x) { return (x + MiB - 1) / MiB * MiB; }
constexpr size_t WS_CTL = 0, CTL_ZERO_BYTES = 1 * MiB;
constexpr size_t WS_W1C = 1 * MiB;
constexpr size_t WS_W1D = WS_W1C + al((size_t)NCAT * DM * 2);
constexpr size_t WS_WIN = WS_W1D + al((size_t)DM * FF * 2);
constexpr size_t WS_WOUT = WS_WIN + al((size_t)NIN * DM * 2);
constexpr size_t WS_W2C = WS_WOUT + al((size_t)DM * DM * 2);
constexpr size_t WS_W2D = WS_W2C + al((size_t)NCAT * DM * 2);
constexpr size_t WS_WPG = WS_W2D + al((size_t)DM * FF * 2);
constexpr size_t WS_WPP = WS_WPG + al((size_t)DM * DM * 2);
constexpr size_t WS_WPOOL = WS_WPP + al((size_t)DM * PLE * 2);
constexpr size_t WS_HB = WS_WPOOL + al((size_t)PWID * 256 * 2);
constexpr size_t WS_G = WS_HB + al((size_t)M * DM * 2);
constexpr size_t WS_QB = WS_G + al((size_t)M * FF * 2);
constexpr size_t WS_KB = WS_QB + al((size_t)M * SBW * 2);
constexpr size_t WS_VB = WS_KB + al((size_t)M * SBW * 2);
constexpr size_t WS_XP = WS_VB + al((size_t)M * SBW * 2);
constexpr size_t WS_PLB = WS_XP + al((size_t)M * PWID * 2);
constexpr size_t WS_C = WS_PLB + al((size_t)M * PWID * 2);
constexpr size_t WS_PROJ = WS_C + al((size_t)M * DM * 2);
constexpr size_t WS_PB = WS_PROJ + al((size_t)M * DM * 2);
constexpr size_t WS_SLAB = WS_PB + al((size_t)M * PLE * 2);
constexpr size_t WS_END = WS_SLAB + 4 * MiB;
constexpr int CW_BAR = 4096;
constexpr int CW_RANK = 12288;
constexpr int CW_CNT = 8192;
constexpr int CW_SSQ = 16384;
constexpr int SSQ_STRIDE = 8704;
static_assert((CW_SSQ + 7 * SSQ_STRIDE) * 4 <= (int)CTL_ZERO_BYTES && SSQ_STRIDE >= M, "CTL words inside the memset region");

constexpr int RING_OFF = 0, RING_BYTES = 131072;
constexpr int LDSCTL_OFF = RING_BYTES, MISC_OFF = LDSCTL_OFF + 320;
constexpr int LDS_BYTES = 147456;

__device__ __forceinline__ float wave_sum(float v) {
#pragma unroll
    for (int o = 1; o < 64; o <<= 1) v += __shfl_xor(v, o);
    return v;
}

#define XB_TMO      128
#define XB_XCNT(j)  (256  + 64 * (j))
#define XB_XSUB(j)  (1280 + 64 * (j))
#define XB_XGEN(j)  (2304 + 64 * (j))
#define XB_TOP      3328
#define XB_TOPGEN   3392
#define XCD_BAR_WORDS 3456
#define XB_SPIN_CAP (1u << 18)
__device__ __forceinline__ unsigned xb_ld(unsigned* p)              { return __hip_atomic_load(p, __ATOMIC_RELAXED, __HIP_MEMORY_SCOPE_AGENT); }
__device__ __forceinline__ unsigned xb_add(unsigned* p, unsigned v) { return __hip_atomic_fetch_add(p, v, __ATOMIC_RELAXED, __HIP_MEMORY_SCOPE_AGENT); }
__device__ __forceinline__ unsigned xb_xcc_id() { return (unsigned)__builtin_amdgcn_s_getreg((3 << 11) | 20) & 0xFu; }
#define XB_SPIN(cond, bar) do { unsigned _sp = 0; while (cond) { __builtin_amdgcn_s_sleep(1); \
    if ((++_sp & 255u) == 0u) { if (xb_ld(&(bar)[XB_TMO])) break; if (_sp > XB_SPIN_CAP) { atomicAdd(&(bar)[XB_TMO], 1u); break; } } } } while (0)
struct XcdBarrier { unsigned* bar; unsigned x; volatile LAS unsigned* st; };
__device__ __forceinline__ XcdBarrier xcd_barrier_post(unsigned* bar, volatile LAS unsigned* st) {
    XcdBarrier b; b.bar = bar; b.x = xb_xcc_id(); b.st = st;
    if (threadIdx.x == 0) (void)xb_add(&bar[XB_XCNT(b.x)], 1u);
    return b;
}
__device__ __forceinline__ void xcd_barrier_complete(unsigned* bar, unsigned x, unsigned& nloc, unsigned& nx) {
    const unsigned G = gridDim.x * gridDim.y * gridDim.z;
    unsigned sum, cnt, mine, sp = 0u;
    for (;;) {
        sum = 0u; cnt = 0u; mine = 0u;
#pragma unroll
        for (unsigned j = 0; j < 16; ++j) { const unsigned c = xb_ld(&bar[XB_XCNT(j)]); sum += c; cnt += (c > 0u) ? 1u : 0u; mine = (j == x) ? c : mine; }
        if (sum == G) break;
        __builtin_amdgcn_s_sleep(1);
        if ((++sp & 255u) == 0u) { if (xb_ld(&bar[XB_TMO])) break; if (sp > XB_SPIN_CAP) { atomicAdd(&bar[XB_TMO], 1u); break; } }
    }
    nloc = mine > 0u ? mine : 1u; nx = cnt > 0u ? cnt : 1u;
}
__device__ __forceinline__ void xcd_barrier(const XcdBarrier& b) {
    asm volatile("s_waitcnt vmcnt(0)" ::: "memory");
    __syncthreads();
    if (threadIdx.x == 0) {
        unsigned* bar = b.bar;
        __builtin_amdgcn_s_waitcnt(0);
        unsigned nloc = b.st[0], nx = b.st[1];
        if (nloc == 0u) { xcd_barrier_complete(bar, b.x, nloc, nx); b.st[0] = nloc; b.st[1] = nx; }
        const unsigned old = xb_add(&bar[XB_XSUB(b.x)], 1u);
        const unsigned gen = old / nloc;
        if (old + 1u == (gen + 1u) * nloc) {
            __builtin_amdgcn_fence(__ATOMIC_RELEASE, "agent");
            asm volatile("s_waitcnt vmcnt(0)" ::: "memory");
            const unsigned og = xb_add(&bar[XB_TOP], 1u);
            const unsigned tg = og / nx;
            if (og + 1u == (tg + 1u) * nx) xb_add(&bar[XB_TOPGEN], 1u);
            else XB_SPIN(xb_ld(&bar[XB_TOPGEN]) == tg, bar);
            __builtin_amdgcn_fence(__ATOMIC_ACQUIRE, "agent");
            xb_add(&bar[XB_XGEN(b.x)], 1u);
            asm volatile("s_waitcnt vmcnt(0)" ::: "memory");
        } else {
            XB_SPIN(xb_ld(&bar[XB_XGEN(b.x)]) == gen, bar);
            __builtin_amdgcn_fence(__ATOMIC_ACQUIRE, "agent");
            asm volatile("s_waitcnt vmcnt(0)" ::: "memory");
        }
    }
    __syncthreads();
}

struct Frame {
    LAS unsigned char* lds;
    volatile LAS unsigned* MISC;
    unsigned* ctl; unsigned char* ws;
    int tid, lane, wave, vcu, G;
    const float* in[25];
    float* out;
    bf16 *W1C, *W1D, *WIN, *WOUT, *W2C, *W2D, *WPG, *WPP, *WPOOL;
    bf16 *HB, *GB, *QB, *KB, *VB, *PLB, *CB, *PROJ, *PB;
    bf16* XP;
    float *ssq0, *ssq1, *ssqA, *ssqP, *ssq2, *ssq3, *ssq4;
};
enum { I_XP = 0, I_XS, I_CK, I_CV, I_SPOOL, I_PP, I_PS, I_GFFN1, I_W1G, I_W1U, I_W1D, I_GMIX, I_WIN, I_GATT, I_WPOOL, I_PSCALE, I_WOUT, I_GFFN2, I_W2G, I_W2U, I_W2D, I_GPLE, I_WPG, I_WPP, I_GFINAL };

constexpr int TRP = 66;
__device__ __forceinline__ void tr_item(const float* W, int N, const float* ga, bf16* WT, int Kdst, int k0, int n0, int drow0, LAS unsigned short* scr, int lane) {
    const int r4 = lane >> 4, c4 = lane & 15;
    f32x4 v[16];
#pragma unroll
    for (int i = 0; i < 16; ++i) v[i] = __builtin_nontemporal_load((const GAS f32x4*)(W + (size_t)(k0 + 4 * i + r4) * N + n0 + 4 * c4));
#pragma unroll
    for (int i = 0; i < 16; ++i) { f32x4 x = v[i]; if (ga) x = x * ga[k0 + 4 * i + r4];
        const v2u w = pk4(x); LAS unsigned* d = (LAS unsigned*)(scr + (4 * i + r4) * TRP + 4 * c4); d[0] = w.x; d[1] = w.y; }
    LDS_WAIT(); asm volatile("" ::: "memory");
    const int c = lane & 7;
#pragma unroll
    for (int j = 0; j < 8; ++j) { const int n = (lane >> 3) + 8 * j; const LAS unsigned short* p = scr + (8 * c) * TRP + n;
        v4u o; o.x = (unsigned)p[0] | ((unsigned)p[TRP] << 16); o.y = (unsigned)p[2 * TRP] | ((unsigned)p[3 * TRP] << 16); o.z = (unsigned)p[4 * TRP] | ((unsigned)p[5 * TRP] << 16); o.w = (unsigned)p[6 * TRP] | ((unsigned)p[7 * TRP] << 16);
        *(GAS v4u*)(WT + (size_t)(drow0 + n) * Kdst + k0 + 8 * c) = o; }
    LDS_WAIT(); asm volatile("" ::: "memory");
}
__device__ __forceinline__ void tr_plain(const float* W, int K, int N, const float* ga, const float* gb, int ghalf, bf16* WT, int r, LAS unsigned short* scr, int lane) {
    const int nblk = N / 64, kb = r / nblk, nb = r % nblk; const float* gk = (64 * kb < ghalf) ? ga : gb;
    tr_item(W, N, gk, WT, K, 64 * kb, 64 * nb, 64 * nb, scr, lane);
}
__device__ __forceinline__ void tr_cat(const float* W, const float* ga, bf16* WT, int half, int r, LAS unsigned short* scr, int lane) {
    const int nblk = FF / 64, kb = r / nblk, nb = r % nblk, n0 = 64 * nb; tr_item(W, FF, ga, WT, DM, 64 * kb, n0, (n0 >> 7) * 256 + half * 128 + (n0 & 127), scr, lane);
}
__device__ __forceinline__ void p0_prologue(Frame& F) {
    LAS unsigned short* scr = (LAS unsigned short*)(F.lds + RING_OFF + F.wave * 16384);
    const int gw = F.vcu * NWAVES + F.wave, NGW = F.G * NWAVES;
    constexpr int I_CAT = (DM / 64) * (FF / 64), I_DN = (FF / 64) * (DM / 64), I_IN = (DM / 64) * (NIN / 64), I_SQ = (DM / 64) * (DM / 64), I_PPJ = (PLE / 64) * (DM / 64), I_PL = 4 * (256 / 64) * (256 / 64);
    constexpr int NITEMS = 4 * I_CAT + 2 * I_DN + I_IN + 2 * I_SQ + I_PPJ + I_PL;
    constexpr int NLATE = NITEMS - 2 * I_CAT;
    for (int it = gw; it < NLATE; it += NGW) {
        int r = it;
        if (r < I_SQ) { tr_plain(F.in[I_WPG], DM, DM, F.in[I_GPLE], nullptr, 1 << 30, F.WPG, r, scr, F.lane); continue; } r -= I_SQ;
        if (r < I_DN) { tr_plain(F.in[I_W2D], FF, DM, nullptr, nullptr, 0, F.W2D, r, scr, F.lane); continue; } r -= I_DN;
        if (r < I_CAT) { tr_cat(F.in[I_W2U], F.in[I_GFFN2], F.W2C, 1, r, scr, F.lane); continue; } r -= I_CAT;
        if (r < I_CAT) { tr_cat(F.in[I_W2G], F.in[I_GFFN2], F.W2C, 0, r, scr, F.lane); continue; } r -= I_CAT;
        if (r < I_SQ) { tr_plain(F.in[I_WOUT], DM, DM, F.in[I_GATT], F.in[I_PSCALE] - SBW, SBW, F.WOUT, r, scr, F.lane); continue; } r -= I_SQ;
        if (r < I_PL) { const int g = r / 16, rr = r % 16; tr_plain(F.in[I_WPOOL] + (size_t)g * 65536, 256, 256, nullptr, nullptr, 0, F.WPOOL + (size_t)g * 65536, rr, scr, F.lane); continue; } r -= I_PL;
        if (r < I_IN) { tr_plain(F.in[I_WIN], DM, NIN, F.in[I_GMIX], nullptr, 1 << 30, F.WIN, r, scr, F.lane); continue; } r -= I_IN;
        if (r < I_DN) { tr_plain(F.in[I_W1D], FF, DM, nullptr, nullptr, 0, F.W1D, r, scr, F.lane); continue; } r -= I_DN;
        tr_plain(F.in[I_WPP], PLE, DM, nullptr, nullptr, 0, F.WPP, r, scr, F.lane);
    }
    for (int m0 = gw; m0 < M; m0 += 2 * NGW) {
        const int m1 = m0 + NGW; const bool two = m1 < M;
        const float* xr0 = (m0 < MP) ? F.in[I_XP] + (size_t)m0 * DM : F.in[I_XS] + (size_t)(m0 - MP) * DM;
        const float* pr0 = (m0 < MP) ? F.in[I_PP] + (size_t)m0 * PLE : F.in[I_PS] + (size_t)(m0 - MP) * PLE;
        const int mm1 = two ? m1 : m0;
        const float* xr1 = (mm1 < MP) ? F.in[I_XP] + (size_t)mm1 * DM : F.in[I_XS] + (size_t)(mm1 - MP) * DM;
        const float* pr1 = (mm1 < MP) ? F.in[I_PP] + (size_t)mm1 * PLE : F.in[I_PS] + (size_t)(mm1 - MP) * PLE;
        f32x4 v0[8], v1[8]; float s0 = 0.f, s1 = 0.f;
#pragma unroll
        for (int j = 0; j < 8; ++j) { v0[j] = __builtin_nontemporal_load((const GAS f32x4*)xr0 + F.lane + 64 * j); v1[j] = __builtin_nontemporal_load((const GAS f32x4*)xr1 + F.lane + 64 * j); }
        const f32x4 p0 = ((const GAS f32x4*)pr0)[F.lane], p1 = ((const GAS f32x4*)pr1)[F.lane];
#pragma unroll
        for (int j = 0; j < 8; ++j) { s0 += pg8::dot4(v0[j]); s1 += pg8::dot4(v1[j]); }
        s0 = wave_sum(s0); s1 = wave_sum(s1);
        if (F.lane == 0) { F.ssq0[m0] = s0; if (two) F.ssq0[m1] = s1; }
        GAS v2u* o0 = (GAS v2u*)(F.HB + (size_t)m0 * DM) + F.lane; GAS v2u* o1 = (GAS v2u*)(F.HB + (size_t)mm1 * DM) + F.lane;
#pragma unroll
        for (int j = 0; j < 8; ++j) o0[64 * j] = pk4(v0[j]);
        ((GAS v2u*)(F.PB + (size_t)m0 * PLE))[F.lane] = pk4(p0);
        if (two) {
#pragma unroll
            for (int j = 0; j < 8; ++j) o1[64 * j] = pk4(v1[j]);
            ((GAS v2u*)(F.PB + (size_t)m1 * PLE))[F.lane] = pk4(p1); }
    }
    for (int it = gw; it < 2 * I_CAT; it += NGW) { if (it < I_CAT) tr_cat(F.in[I_W1G], F.in[I_GFFN1], F.W1C, 0, it, scr, F.lane); else tr_cat(F.in[I_W1U], F.in[I_GFFN1], F.W1C, 1, it - I_CAT, scr, F.lane); }
}

__device__ __forceinline__ int crow(int r, int hi) { return (r & 3) + 8 * (r >> 2) + 4 * hi; }
__device__ __forceinline__ bf16x8 cvt8(f32x4 a, f32x4 b) { v4u w; w.x = pk2(a[0], a[1]); w.y = pk2(a[2], a[3]); w.z = pk2(b[0], b[1]); w.w = pk2(b[2], b[3]); return __builtin_bit_cast(bf16x8, w); }
typedef short v4i16_t __attribute__((ext_vector_type(4)));
__device__ __forceinline__ s16x4 vtr(LAS const unsigned char* p) { return __builtin_bit_cast(s16x4, __builtin_amdgcn_ds_read_tr16_b64_v4i16((LAS v4i16_t*)p)); }
constexpr int VPITCH = 272;
constexpr int VIMG_BYTES = 32 * VPITCH;
constexpr float SB_STOP = -135.0f;
constexpr bool DYN_POOL = true;
constexpr int TA_S = 5;

template <bool SAMPLE>
__device__ __forceinline__ void sb_unit(const Frame& F, int b, int h, int qblk, LAS unsigned char* vl, bool dry = false) {
    const int lane = F.lane, qi = lane & 31, hi = lane >> 5;
    const int qrow = SAMPLE ? MP + b * DECS + qi : b * SEQ + qblk * 32 + qi;
    const bf16* qp = F.QB + (size_t)qrow * SBW + h * HD + hi * 8;
    bf16x8 qreg[8];
    if (!SAMPLE) {
#pragma unroll
        for (int ds = 0; ds < 8; ++ds) qreg[ds] = *(const bf16x8*)(qp + ds * 16); }
    f32x16 o[4];
#pragma unroll
    for (int db = 0; db < 4; ++db)
#pragma unroll
        for (int r = 0; r < 16; ++r) o[db][r] = 0.f;
    float R = 0.f;
    const int nblk = SAMPLE ? (PAST / 32 + 1) : qblk + 1;
    const int tr_base = ((4 * (lane >> 5) + ((lane & 15) >> 2)) * VPITCH) + (16 * ((lane >> 4) & 1) + 4 * (lane & 3)) * 2;
    const int srow0 = SAMPLE ? MP + b * DECS : b * SEQ;
    bf16x8 kf[8];
    if (!SAMPLE) { const bf16* kp = F.KB + (size_t)(srow0 + (nblk - 1) * 32 + qi) * SBW + h * HD + hi * 8;
#pragma unroll
      for (int ds = 0; ds < 8; ++ds) kf[ds] = *(const bf16x8*)(kp + ds * 16); }
    { unsigned tx = 0;
      if (SAMPLE) { unsigned tch[8 * TA_S + 4];
          { const size_t ro = (size_t)(srow0 + (lane & 31)) * SBW + h * HD + (lane >> 5) * 32;
            tch[8 * TA_S] = *(const GAS unsigned*)(F.KB + ro); tch[8 * TA_S + 1] = *(const GAS unsigned*)(F.KB + ro + 64); tch[8 * TA_S + 2] = *(const GAS unsigned*)(F.VB + ro); tch[8 * TA_S + 3] = *(const GAS unsigned*)(F.VB + ro + 64); }
#pragma unroll
          for (int i = 0; i < TA_S; ++i) { const size_t ro = (size_t)(b * PAST + (PAST / 32 - 1 - i) * 32 + (lane & 31)) * SBW + h * HD + (lane >> 5) * 16;
#pragma unroll
              for (int t = 0; t < 4; ++t) { tch[8 * i + t] = *(const GAS unsigned*)(F.in[I_CK] + ro + t * 32); tch[8 * i + 4 + t] = *(const GAS unsigned*)(F.in[I_CV] + ro + t * 32); } }
#pragma unroll
          for (int i = 0; i < 8 * TA_S + 4; ++i) tx ^= tch[i];
      }
      asm volatile("" :: "v"(tx)); }
    const unsigned vby_f32 = (unsigned)((lane >> 5) * SBW + (lane & 31) * 4) * 4u;
    const unsigned vby_b16 = (unsigned)((lane >> 4) * SBW + (lane & 15) * 8) * 2u;
    LAS unsigned char* const vl_f32 = vl + (lane >> 5) * VPITCH + (lane & 31) * 8;
    LAS unsigned char* const vl_b16 = vl + (lane >> 4) * VPITCH + (lane & 15) * 16;
    v4u vr[8];
    if (!SAMPLE) {
        const bf16* vp = F.VB + (size_t)(srow0 + (nblk - 1) * 32) * SBW + h * HD;
#pragma unroll
        for (int i = 0; i < 8; ++i) { const char* pb = (const char*)vp + (size_t)i * 4 * SBW * 2; asm volatile("" : "+s"(pb)); vr[i] = *(const GAS v4u*)(pb + vby_b16); } }
    for (int j = nblk - 1; j >= 0; --j) {
        const bool diag = (j == nblk - 1);
        const bool from_cache = SAMPLE && !diag;
        f32x16 st;
#pragma unroll
        for (int r = 0; r < 16; ++r) st[r] = 0.f;
        if (!from_cache) {
            if (SAMPLE) { const bf16* vp = F.VB + (size_t)srow0 * SBW + h * HD;
#pragma unroll
            for (int i = 0; i < 8; ++i) { const char* pb = (const char*)vp + (size_t)i * 4 * SBW * 2; asm volatile("" : "+s"(pb)); vr[i] = *(const GAS v4u*)(pb + vby_b16); } }
            else {
#pragma unroll
                for (int i = 0; i < 8; ++i) *(LAS v4u*)(vl_b16 + i * 4 * VPITCH) = vr[i];
                if (j > 0) { const bf16* vp = F.VB + (size_t)(srow0 + (j - 1) * 32) * SBW + h * HD;
#pragma unroll
                    for (int i = 0; i < 8; ++i) { const char* pb = (const char*)vp + (size_t)i * 4 * SBW * 2; asm volatile("" : "+s"(pb)); vr[i] = *(const GAS v4u*)(pb + vby_b16); } } }
            if (SAMPLE) { const bf16* kp = F.KB + (size_t)(srow0 + qi) * SBW + h * HD + hi * 8;
#pragma unroll
                for (int ds = 0; ds < 8; ++ds) kf[ds] = *(const bf16x8*)(kp + ds * 16); }
#pragma unroll
            for (int ds = 0; ds < 8; ++ds) { bf16x8 qf; if (SAMPLE) qf = *(const bf16x8*)(qp + ds * 16); else qf = qreg[ds]; st = __builtin_amdgcn_mfma_f32_32x32x16_bf16(kf[ds], qf, st, 0, 0, 0); }
            if (!SAMPLE && j > 0) {
                const bf16* kp = F.KB + (size_t)(srow0 + (j - 1) * 32 + qi) * SBW + h * HD + hi * 8;
#pragma unroll
                for (int ds = 0; ds < 8; ++ds) kf[ds] = *(const bf16x8*)(kp + ds * 16); }
        } else {
            const float* kp = F.in[I_CK] + ((size_t)(b * PAST + j * 32 + qi) * SBW + h * HD + hi * 8);
            const float* vp = F.in[I_CV] + ((size_t)(b * PAST + j * 32) * SBW + h * HD);
#pragma unroll
            for (int hf = 0; hf < 2; ++hf) { f32x4 ka[4], kb[4];
#pragma unroll
              for (int d4 = 0; d4 < 4; ++d4) { ka[d4] = *(const f32x4*)(kp + (hf * 4 + d4) * 16); kb[d4] = *(const f32x4*)(kp + (hf * 4 + d4) * 16 + 4); }
#pragma unroll
              for (int d4 = 0; d4 < 4; ++d4) { const bf16x8 qf = *(const bf16x8*)(qp + (hf * 4 + d4) * 16); st = __builtin_amdgcn_mfma_f32_32x32x16_bf16(cvt8(ka[d4], kb[d4]), qf, st, 0, 0, 0); }
              asm volatile("" ::: "memory"); }
            { f32x4 vf[16];
#pragma unroll
              for (int i = 0; i < 16; ++i) { const char* pb = (const char*)vp + (size_t)i * 2 * SBW * 4; asm volatile("" : "+s"(pb)); vf[i] = *(const GAS f32x4*)(pb + vby_f32); }
#pragma unroll
              for (int i = 0; i < 16; ++i) *(LAS v2u*)(vl_f32 + i * 2 * VPITCH) = pk4(vf[i]); }
            asm volatile("" ::: "memory");
        }
        bf16x8 vaf[2][2];
        if (!SAMPLE) {
#pragma unroll
            for (int db = 0; db < 2; ++db)
#pragma unroll
                for (int s = 0; s < 2; ++s) { const LAS unsigned char* p = vl + tr_base + (16 * s) * VPITCH + db * 64;
                    const s16x4 lo = vtr(p), hi4 = vtr(p + 8 * VPITCH);
                    vaf[db][s] = (bf16x8){lo[0], lo[1], lo[2], lo[3], hi4[0], hi4[1], hi4[2], hi4[3]}; }
        }
        float bt[16], om[16];
#pragma unroll
        for (int r = 0; r < 16; ++r) { const float z = fmaxf(st[r], -125.0f);
            const float t = __builtin_amdgcn_exp2f(-z); float b_ = __builtin_amdgcn_rcpf(1.0f + t); float o_ = t * b_;
            if (diag && !(crow(r, hi) < qi)) { b_ = 0.f; o_ = 1.f; }
            bt[r] = b_; om[r] = o_; }
        float e[16], gs[4], pg[4];
#pragma unroll
        for (int g = 0; g < 4; ++g) { e[4 * g + 3] = 1.f; e[4 * g + 2] = om[4 * g + 3]; e[4 * g + 1] = e[4 * g + 2] * om[4 * g + 2]; e[4 * g] = e[4 * g + 1] * om[4 * g + 1]; gs[g] = e[4 * g] * om[4 * g]; }
#pragma unroll
        for (int g = 0; g < 4; ++g) pg[g] = __shfl_xor(gs[g], 32);
        const float scale = __builtin_amdgcn_exp2f(R);
        float after = 1.f; float a[16];
#pragma unroll
        for (int g = 3; g >= 0; --g) { const float tail = scale * after * (hi == 0 ? pg[g] : 1.f);
#pragma unroll
            for (int i = 0; i < 4; ++i) { const int r = 4 * g + i; a[r] = bt[r] * e[r] * tail; }
            after *= gs[g] * pg[g]; }
        R += __builtin_amdgcn_logf(after);
        bf16x8 xf[2];
#pragma unroll
        for (int s = 0; s < 2; ++s) { v4u w; w.x = pk2(a[8 * s + 0], a[8 * s + 1]); w.y = pk2(a[8 * s + 2], a[8 * s + 3]); w.z = pk2(a[8 * s + 4], a[8 * s + 5]); w.w = pk2(a[8 * s + 6], a[8 * s + 7]); xf[s] = __builtin_bit_cast(bf16x8, w); }
        asm volatile("" ::: "memory");
        if (SAMPLE && !from_cache) {
#pragma unroll
            for (int i = 0; i < 8; ++i) *(LAS v4u*)(vl_b16 + i * 4 * VPITCH) = vr[i];
        }
        LDS_WAIT();
#pragma unroll
        for (int db = 0; db < 4; ++db)
#pragma unroll
            for (int s = 0; s < 2; ++s) { bf16x8 va;
                if (!SAMPLE && db < 2) va = vaf[db][s];
                else { const LAS unsigned char* p = vl + tr_base + (16 * s) * VPITCH + db * 64;
                    const s16x4 lo = vtr(p), hi4 = vtr(p + 8 * VPITCH);
                    va = (bf16x8){lo[0], lo[1], lo[2], lo[3], hi4[0], hi4[1], hi4[2], hi4[3]}; }
                o[db] = __builtin_amdgcn_mfma_f32_32x32x16_bf16(va, xf[s], o[db], 0, 0, 0); }
        LDS_WAIT(); asm volatile("" ::: "memory");
        if (__all(R < SB_STOP)) break;
    }
    float s = 0.f;
#pragma unroll
    for (int db = 0; db < 4; ++db)
#pragma unroll
        for (int r = 0; r < 16; ++r) s += o[db][r] * o[db][r];
    s += __shfl_xor(s, 32);
    if (hi == 0 && !dry) atomicAdd(F.ssqA + qrow, s);
    bf16* cp = F.CB + (size_t)qrow * DM + h * HD + 4 * hi;
#pragma unroll
    for (int db = 0; db < 4; ++db)
#pragma unroll
        for (int g = 0; g < 4; ++g) { v2u w; w.x = pk2(o[db][4 * g], o[db][4 * g + 1]); w.y = pk2(o[db][4 * g + 2], o[db][4 * g + 3]); *(v2u*)(cp + 32 * db + 8 * g) = w; }
}

__device__ __forceinline__ f32x4 ld_bf4(const bf16* p) { const v2u w = *(const v2u*)p; return (f32x4){pg8::bf_lo(w.x), pg8::bf_hi(w.x), pg8::bf_lo(w.y), pg8::bf_hi(w.y)}; }
template <int W>
__device__ __forceinline__ void pool_chunk(const bf16* xsrc, const float* past, int t0, int L, int pos0, bf16* dst, int g, int lane) {
    const int c = g * 256 + lane * 4;
    f32x4 hist[16];
#pragma unroll
    for (int j = 0; j < 16; ++j) { const int t = t0 - 16 + j; f32x4 v = (f32x4){0.f, 0.f, 0.f, 0.f};
        if (t >= 0) v = ld_bf4(xsrc + (size_t)t * PWID + c); else if (past && t >= -PSTATE) v = *(const f32x4*)(past + (size_t)(PSTATE + t) * PWID + c);
        hist[j] = v; }
    f32x4 S = (f32x4){0.f, 0.f, 0.f, 0.f};
#pragma unroll
    for (int i = 1; i <= W; ++i) S += hist[16 - i];
    for (int tb = t0; tb < t0 + L; tb += 16) {
        v2u xraw[16];
#pragma unroll
        for (int j = 0; j < 16; ++j) xraw[j] = *(const v2u*)(xsrc + (size_t)(tb + j) * PWID + c);
#pragma unroll
        for (int j = 0; j < 16; ++j) { const int t = tb + j; const f32x4 xn = (f32x4){pg8::bf_lo(xraw[j].x), pg8::bf_hi(xraw[j].x), pg8::bf_lo(xraw[j].y), pg8::bf_hi(xraw[j].y)};
            S += xn - hist[(j - W) & 15]; hist[j] = xn;
            const int pc = pos0 + t + 1; const float cnt = (float)(pc < W ? pc : W);
            const float icnt = 1.0f / cnt; const f32x4 pooled = S * icnt - xn;
            *(v2u*)(dst + (size_t)t * PWID + c) = pk4(pooled); }
    }
}
__device__ __forceinline__ void pool_unit(const Frame& F, int id) {
    const bf16* xsrc; const float* past = nullptr; bf16* dst; int t0, L, pos0, g;
    if (id < 512) { const int b = id >> 7; g = (id >> 5) & 3; const int ch = id & 31; xsrc = F.XP + (size_t)b * SEQ * PWID; dst = F.PLB + (size_t)b * SEQ * PWID; t0 = ch * 64; L = 64; pos0 = 0; }
    else { const int k = id - 512, b = k >> 2; g = k & 3; xsrc = F.XP + (size_t)(MP + b * DECS) * PWID; dst = F.PLB + (size_t)(MP + b * DECS) * PWID; past = F.in[I_SPOOL] + (size_t)b * PSTATE * PWID; t0 = 0; L = DECS; pos0 = PAST; }
    if (g == 0) pool_chunk<2>(xsrc, past, t0, L, pos0, dst, g, F.lane);
    else if (g == 1) pool_chunk<4>(xsrc, past, t0, L, pos0, dst, g, F.lane);
    else if (g == 2) pool_chunk<8>(xsrc, past, t0, L, pos0, dst, g, F.lane);
    else pool_chunk<16>(xsrc, past, t0, L, pos0, dst, g, F.lane);
}

__device__ __forceinline__ void publish_count(unsigned* cnt) {
    VM_WAIT(); __syncthreads();
    if (threadIdx.x == 0) { __builtin_amdgcn_fence(__ATOMIC_RELEASE, "agent"); VM_WAIT(); (void)__hip_atomic_fetch_add(cnt, 1u, __ATOMIC_RELAXED, __HIP_MEMORY_SCOPE_AGENT); }
}
__device__ __forceinline__ void wait_count(unsigned* cnt, unsigned need, unsigned* tmo) {
    if (threadIdx.x == 0) { unsigned sp = 0;
        while (__hip_atomic_load(cnt, __ATOMIC_RELAXED, __HIP_MEMORY_SCOPE_AGENT) < need) { __builtin_amdgcn_s_sleep(8); if (++sp > (1u << 22)) { atomicAdd(tmo, 1u); break; } }
        __builtin_amdgcn_fence(__ATOMIC_ACQUIRE, "agent"); VM_WAIT(); }
    __syncthreads();
}

__device__ __forceinline__ void xcd_local_barrier(unsigned* cntx, unsigned nloc, unsigned* tmo) {
    VM_WAIT(); __syncthreads();
    if (threadIdx.x == 0) {
        const unsigned old = __hip_atomic_fetch_add(cntx, 1u, __ATOMIC_RELAXED, __HIP_MEMORY_SCOPE_AGENT); const unsigned want = (old / nloc + 1u) * nloc; unsigned sp = 0;
        while (__hip_atomic_load(cntx, __ATOMIC_RELAXED, __HIP_MEMORY_SCOPE_AGENT) < want) { __builtin_amdgcn_s_sleep(1); if (++sp > (1u << 21)) { atomicAdd(tmo, 1u); break; } }
        __builtin_amdgcn_fence(__ATOMIC_ACQUIRE, "agent"); VM_WAIT(); }
    __syncthreads();
}

struct EpiPleFinal {
    static constexpr bool AFTER_DRAIN = false, MID = false, FINAL = true;
    float* y; const pg8::bf16_t* hb; const pg8::bf16_t* proj; const float* ssq; float inv_w; float* ssq4; const float* gfin;
    int mode; unsigned* cnt; unsigned need; unsigned* tmo; XcdBarrier bar;
    template <class Src> __device__ __forceinline__ void run(const Src&, const pg8::Unit&, int, int, int, int) const {}
    __device__ __forceinline__ void run_final(pg8::f32x4 (&acc)[2][2][4][2], const pg8::Unit& u, int wr, int wc, int fr, int fq) const {
        using namespace pg8;
        const int row0 = u.pm * BM + wr * 64 + fr, col0 = u.pn * BM + wc * 32 + 4 * fq;
        { float rsv[2][4]; row_scales(ssq, inv_w, row0, rsv);
#pragma unroll
          for (int ai = 0; ai < 2; ++ai) {
            u32x2 hw[4][2][2], pj[4][2][2];
#pragma unroll
            for (int m = 0; m < 4; ++m)
#pragma unroll
                for (int bj = 0; bj < 2; ++bj)
#pragma unroll
                    for (int n = 0; n < 2; ++n) { const size_t o = (size_t)(row0 + ai * HALF + m * 16) * DM + col0 + bj * HALF + n * 16; hw[m][bj][n] = *(const u32x2*)(hb + o); pj[m][bj][n] = *(const u32x2*)(proj + o); }
#pragma unroll
            for (int m = 0; m < 4; ++m) { const int row = row0 + ai * HALF + m * 16; const float r = rsv[ai][m]; float s = 0.f;
#pragma unroll
                for (int bj = 0; bj < 2; ++bj)
#pragma unroll
                    for (int n = 0; n < 2; ++n) { const u32x2 w = hw[m][bj][n], p = pj[m][bj][n]; const f32x4 b = (f32x4){bf_lo(w.x), bf_hi(w.x), bf_lo(w.y), bf_hi(w.y)};
                        const f32x4 g = acc[ai][bj][m][n] * r; f32x4 v;
                        v[0] = b[0] + sigmoidf_(g[0]) * bf_lo(p.x); v[1] = b[1] + sigmoidf_(g[1]) * bf_hi(p.x); v[2] = b[2] + sigmoidf_(g[2]) * bf_lo(p.y); v[3] = b[3] + sigmoidf_(g[3]) * bf_hi(p.y);
                        acc[ai][bj][m][n] = v; s += dot4(v); }
                s += __shfl_xor(s, 16); s += __shfl_xor(s, 32); if (fq == 0) atomicAdd(ssq4 + row, s); }
          } }
        if (mode == 0) xcd_local_barrier(cnt, 32u, tmo);
        else if (mode == 1) xcd_barrier(bar);
        else { publish_count(cnt); wait_count(cnt, need, tmo); }
        float r4[2][4]; row_scales(ssq4, inv_w, row0, r4);
        f32x4 gv[2][2];
#pragma unroll
        for (int bj = 0; bj < 2; ++bj)
#pragma unroll
            for (int n = 0; n < 2; ++n) gv[bj][n] = *(const f32x4*)(gfin + col0 + bj * HALF + n * 16);
#pragma unroll
        for (int ai = 0; ai < 2; ++ai)
#pragma unroll
            for (int m = 0; m < 4; ++m) { float* yr = y + (size_t)(row0 + ai * HALF + m * 16) * DM + col0; const float r = r4[ai][m];
#pragma unroll
                for (int bj = 0; bj < 2; ++bj)
#pragma unroll
                    for (int n = 0; n < 2; ++n) __builtin_nontemporal_store(acc[ai][bj][m][n] * r * gv[bj][n], (f32x4*)(yr + bj * HALF + n * 16)); }
    }
};

struct Args { const float* in[25]; float* out; unsigned char* ws; int ph_lo, ph_hi; };
__global__ void __launch_bounds__(NWAVES * 64, 2) hymba_fwd(Args args) {
    extern __shared__ __attribute__((aligned(16))) unsigned char lds[];
    Frame F;
    F.lds = (LAS unsigned char*)lds;
    F.MISC = (volatile LAS unsigned*)(F.lds + MISC_OFF);
    F.tid = threadIdx.x; F.lane = F.tid & 63; F.wave = __builtin_amdgcn_readfirstlane(F.tid >> 6);
    F.G = gridDim.x; { const int bx = blockIdx.x; F.vcu = (F.G % 8 == 0) ? (bx % 8) * (F.G / 8) + bx / 8 : bx; }
    unsigned char* ws = args.ws;
    F.ctl = (unsigned*)(ws + WS_CTL); F.ws = ws;
#pragma unroll
    for (int i = 0; i < 25; ++i) F.in[i] = args.in[i];
    F.out = args.out;
    F.W1C = (bf16*)(ws + WS_W1C); F.W1D = (bf16*)(ws + WS_W1D); F.WIN = (bf16*)(ws + WS_WIN); F.WOUT = (bf16*)(ws + WS_WOUT); F.W2C = (bf16*)(ws + WS_W2C); F.W2D = (bf16*)(ws + WS_W2D);
    F.WPG = (bf16*)(ws + WS_WPG); F.WPP = (bf16*)(ws + WS_WPP); F.WPOOL = (bf16*)(ws + WS_WPOOL);
    F.HB = (bf16*)(ws + WS_HB); F.GB = (bf16*)(ws + WS_G); F.QB = (bf16*)(ws + WS_QB); F.KB = (bf16*)(ws + WS_KB); F.VB = (bf16*)(ws + WS_VB); F.PLB = (bf16*)(ws + WS_PLB);
    F.CB = (bf16*)(ws + WS_C); F.PROJ = (bf16*)(ws + WS_PROJ); F.PB = (bf16*)(ws + WS_PB); F.XP = (bf16*)(ws + WS_XP);
    { float* sq = (float*)(F.ctl + CW_SSQ); F.ssq0 = sq; F.ssq1 = sq + SSQ_STRIDE; F.ssqA = sq + 2 * SSQ_STRIDE; F.ssqP = sq + 3 * SSQ_STRIDE; F.ssq2 = sq + 4 * SSQ_STRIDE; F.ssq3 = sq + 5 * SSQ_STRIDE; F.ssq4 = sq + 6 * SSQ_STRIDE; }
    for (int u = F.tid; u < (LDS_BYTES - LDSCTL_OFF) / 4; u += NWAVES * 64) ((LAS unsigned*)(F.lds + LDSCTL_OFF))[u] = 0u;
    __syncthreads();
    const unsigned xcc = xb_xcc_id();
    if (F.tid == 0) F.MISC[20] = __hip_atomic_fetch_add(F.ctl + CW_RANK + 64 * xcc, 1u, __ATOMIC_RELAXED, __HIP_MEMORY_SCOPE_AGENT);
    XcdBarrier bar; bar.bar = (unsigned*)(F.ctl + CW_BAR); bar.x = 0; bar.st = nullptr;
    if (N_LAUNCHES != PER_PHASE) bar = xcd_barrier_post((unsigned*)(F.ctl + CW_BAR), F.MISC + 8);
#define GRID_BAR() do { if (N_LAUNCHES != PER_PHASE) xcd_barrier(bar); } while (0)
    const int lo = args.ph_lo, hi = args.ph_hi;
#define IN(k) (lo <= (k) && (k) < hi)
#define BOTH(k) (IN(k) && IN((k) + 1))
    float* const H = F.out + OFF_Y;
    const float inv_d = 1.0f / DM, inv_s = 1.0f / SBW;
    const int gw = F.vcu * NWAVES + F.wave, NGW = F.G * NWAVES;

    if (IN(0)) { p0_prologue(F); if (BOTH(0)) GRID_BAR(); }
    bool local_ok = false; int cdyn = (int)blockIdx.x;
    if (N_LAUNCHES != PER_PHASE && !FORCE_GRID_SEAMS) {
        if (F.tid == 0) { unsigned good = (F.G == 256) ? 1u : 0u;
#pragma unroll
            for (int q = 0; q < 16; ++q) { const unsigned c_ = __hip_atomic_load(F.ctl + CW_RANK + 64 * q, __ATOMIC_RELAXED, __HIP_MEMORY_SCOPE_AGENT); if (c_ != (q < 8 ? 32u : 0u)) good = 0u; }
            F.MISC[21] = good; }
        __syncthreads();
        local_ok = F.MISC[21] != 0u;
        if (local_ok) cdyn = (int)F.MISC[20] * 8 + (int)xcc;
    }
    unsigned* const lcnt = F.ctl + CW_RANK + 1024 + 64 * (local_ok ? xcc : 0u);
#define SEAM() do { if (N_LAUNCHES != PER_PHASE) { if (local_ok) xcd_local_barrier(lcnt, 32u, F.ctl + CW_CNT + 512); else xcd_barrier(bar); } } while (0)

    const int xg = cdyn % 8, jg = cdyn / 8;
    const int n1 = (xg < 4) ? 4 : 3;
    const bool s1_on = jg < n1 + 2; const int s1_pn = (xg < 4) ? xg * 6 + jg : 24 + (xg - 4) * 5 + jg;
    unsigned* const cnt = F.ctl + CW_CNT;
    unsigned* const tmo = F.ctl + CW_CNT + 512;
#define GEMM_CALL(EPI, SCHED, g, S, E) pg8::gemm_phase<EPI, SCHED>(F.lds + RING_OFF, g, S, E)
#define PG8_COMMA(a, b) pg8::EpiRes<a, b>
    int one = 1, two = 2, zero = 0; asm volatile("" : "+s"(one), "+s"(two), "+s"(zero));

    if (IN(1)) {
        const pg8::Gemm g1{F.HB, F.W1C, M, NCAT, DM, DM, DM, 0}; const pg8::EpiSwiGLU E1{F.GB, F.ssq0, inv_d};
        pg8::SkewOrder K1; K1.init(MP, NCAT, DM, F.G, cdyn, 0, 4); K1.lo[0] = 2 + n1; K1.lo[1] = 1; K1.lo[2] = 1; K1.lo[3] = 1; K1.lo[4] = 2; K1.lo[5] = 0;
        { pg8::OneTile S{32, s1_pn, DM / 64, s1_on ? one : zero}; GEMM_CALL(pg8::EpiSwiGLU, pg8::OneTile, g1, S, E1); if (s1_on) publish_count(cnt + 0); }
        GEMM_CALL(pg8::EpiSwiGLU, pg8::SkewOrder, g1, K1, E1);
        if (jg == 0) { wait_count(cnt + 0, 44u, tmo);
            pg8::Gemm g{F.GB, F.W1D, M, DM, FF, FF, FF, 0}; pg8::OneTile S{32, xg, FF / 64, one};
            pg8::EpiRes<false, true> E{nullptr, nullptr, F.HB, F.HB, F.ssq1, nullptr, 0.f, 0.5f, nullptr, nullptr, 0.f, nullptr, nullptr, nullptr};
            GEMM_CALL(PG8_COMMA(false, true), pg8::OneTile, g, S, E); publish_count(cnt + 64); }
        if (jg < 2) { wait_count(cnt + 64, 8u, tmo);
            pg8::Gemm g{F.HB, F.WIN, M, NIN, DM, DM, DM, 0}; pg8::OneTile S{32, jg * 8 + xg, DM / 64, one};
            pg8::EpiIn E{F.ssq1, inv_d, F.QB, F.KB, F.VB, F.XP, F.out}; GEMM_CALL(pg8::EpiIn, pg8::OneTile, g, S, E); }
        K1.r0 = 4; K1.r1 = 6; GEMM_CALL(pg8::EpiSwiGLU, pg8::SkewOrder, g1, K1, E1);
        { pg8::Gemm g{F.PB, F.WPP, M, DM, PLE, PLE, PLE, 0}; pg8::OneTile S{32, xg, PLE / 64, jg == 31 ? one : zero};
          pg8::EpiBf E{F.PROJ, DM, 0, nullptr}; GEMM_CALL(pg8::EpiBf, pg8::OneTile, g, S, E); }
        if (BOTH(1)) SEAM();
    }
    if (IN(2)) {
        pg8::Gemm g{F.GB, F.W1D, M, DM, FF, FF, FF, 0}; pg8::StaticOrder S; S.init(MP, DM, FF, F.G, cdyn);
        pg8::EpiRes<false, true> E{nullptr, nullptr, F.HB, F.HB, F.ssq1, nullptr, 0.f, 0.5f, nullptr, nullptr, 0.f, nullptr, nullptr, nullptr};
        GEMM_CALL(PG8_COMMA(false, true), pg8::StaticOrder, g, S, E);
        if (BOTH(2)) SEAM();
    }
    if (IN(3)) {
        pg8::Gemm g{F.HB, F.WIN, M, NIN, DM, DM, DM, 0}; pg8::StaticOrder S; S.init(MP, NIN, DM, F.G, cdyn);
        pg8::EpiIn E{F.ssq1, inv_d, F.QB, F.KB, F.VB, F.XP, F.out}; GEMM_CALL(pg8::EpiIn, pg8::StaticOrder, g, S, E);
        if (BOTH(3)) GRID_BAR();
    }
    if (IN(4)) {
        LAS unsigned char* vl = F.lds + RING_OFF + F.wave * VIMG_BYTES;
        constexpr int NU_S = DECB * NH, NU_P = BATCH * NH * (SEQ / 32);
        { const bool is_s = (F.wave == 0 && F.vcu < NU_S);
          const int nsb = (F.vcu < NU_S ? F.vcu : NU_S) + ((F.wave > 0 && F.vcu < NU_S) ? 1 : 0);
          const int idx = gw - nsb;
          if (is_s) sb_unit<true>(F, F.vcu / NH, F.vcu % NH, 0, vl);
          else {
              { const int k = idx, qblk = (SEQ / 32 - 1) - k / (BATCH * NH), bh = k % (BATCH * NH); sb_unit<false>(F, bh / NH, bh % NH, qblk, vl); }
              if (F.vcu >= 196 && F.vcu < 204) { const int k = (NGW - NU_S) + (F.vcu - 196) * NWAVES + F.wave, qblk = (SEQ / 32 - 1) - k / (BATCH * NH), bh = k % (BATCH * NH); sb_unit<false>(F, bh / NH, bh % NH, qblk, vl); }
          } }
        const int pb = F.vcu - 64;
        if (pb >= 0 && pb < 132) {
            const bool smp = pb >= 128; const int pm = smp ? 32 : (pb >> 2), g = smp ? pb - 128 : (pb & 3);
            if (DYN_POOL) {
                const int nch = smp ? 8 : 4;
                for (;;) { int c = 0; if (F.lane == 0) c = (int)__hip_atomic_fetch_add((LAS unsigned*)(F.lds + MISC_OFF + 22 * 4), 1u, __ATOMIC_RELAXED, __HIP_MEMORY_SCOPE_WORKGROUP);
                    c = __builtin_amdgcn_readfirstlane(c); if (c >= nch) break;
                    if (smp) pool_unit(F, 512 + c * 4 + g); else pool_unit(F, ((pm >> 3) << 7) | (g << 5) | ((pm & 7) * 4 + c)); }
            } else {
            if (smp) pool_unit(F, 512 + F.wave * 4 + g);
            else if (F.wave < 4) pool_unit(F, ((pm >> 3) << 7) | (g << 5) | ((pm & 7) * 4 + F.wave));
            }
            VM_WAIT(); __syncthreads();
            if (F.tid == 0) { __builtin_amdgcn_fence(__ATOMIC_ACQUIRE, "agent"); VM_WAIT(); }
            __syncthreads();
            pg8::Gemm g5{F.PLB, F.WPOOL, M, PWID, 256, PWID, 256, 256}; pg8::EpiBf E5{F.CB, DM, SBW, F.ssqP};
            pg8::OneTile S{pm, g, 256 / 64, one}; GEMM_CALL(pg8::EpiBf, pg8::OneTile, g5, S, E5);
        }
        if (BOTH(4)) GRID_BAR();
    }
    if (IN(6)) {
        pg8::Gemm g{F.CB, F.WOUT, M, DM, DM, DM, DM, 0}; pg8::HalvesOrder S; S.init(MP, DM, DM, F.G, cdyn);
        pg8::EpiRes<true, true> E{nullptr, nullptr, F.HB, F.HB, F.ssq2, F.ssqP, inv_s, 1.0f, F.ssqA, F.ssqP, inv_s, nullptr, nullptr, nullptr};
        GEMM_CALL(PG8_COMMA(true, true), pg8::HalvesOrder, g, S, E);
        if (BOTH(6)) SEAM();
    }
    if (IN(7)) {
        const pg8::Gemm g5{F.HB, F.W2C, M, NCAT, DM, DM, DM, 0}; const pg8::EpiSwiGLU E5{F.GB, F.ssq2, inv_d};
        pg8::SkewOrder K5; K5.init(MP, NCAT, DM, F.G, cdyn, 0, 1); K5.lo[0] = 1; K5.lo[1] = n1 + 2; K5.lo[2] = 1; K5.lo[3] = 1; K5.lo[4] = 1; K5.lo[5] = 1; K5.hi[0] = 31; K5.hi[2] = 31; K5.hi[3] = 31;
        if (jg == 31) { pg8::Gemm g{F.CB, F.WOUT, M, DM, DM, DM, DM, 0}; pg8::OnePiece S{32, xg, 16, 16, one}; pg8::EpiRaw E{(float*)(ws + WS_SLAB + 2 * MiB)};
            GEMM_CALL(pg8::EpiRaw, pg8::OnePiece, g, S, E); publish_count(cnt + 1536 + 64 * xg); }
        if (jg == 0) { pg8::Gemm g{F.CB, F.WOUT, M, DM, DM, DM, DM, 0}; pg8::OnePiece S{32, xg, zero, 16, one};
            pg8::EpiRes<false, true, true, true> E{nullptr, nullptr, F.HB, F.HB, F.ssq2, F.ssqP, inv_s, 1.0f, F.ssqA, F.ssqP, inv_s, (const float*)(ws + WS_SLAB + 2 * MiB), cnt + 1536 + 64 * xg, tmo};
            pg8::gemm_phase<pg8::EpiRes<false, true, true, true>, pg8::OnePiece>(F.lds + RING_OFF, g, S, E); publish_count(cnt + 128); }
        GEMM_CALL(pg8::EpiSwiGLU, pg8::SkewOrder, g5, K5, E5);
        if (s1_on) { wait_count(cnt + 128, 8u, tmo); pg8::OneTile S{32, s1_pn, DM / 64, one}; GEMM_CALL(pg8::EpiSwiGLU, pg8::OneTile, g5, S, E5); publish_count(cnt + 192); }
        K5.r0 = 1; K5.r1 = 2; GEMM_CALL(pg8::EpiSwiGLU, pg8::SkewOrder, g5, K5, E5);
        if (jg == 31) { wait_count(cnt + 192, 44u, tmo);
            pg8::Gemm g{F.GB, F.W2D, M, DM, FF, FF, FF, 0}; pg8::OnePiece S{32, xg, 44, 44, one}; pg8::EpiRaw E{(float*)(ws + WS_SLAB)};
            GEMM_CALL(pg8::EpiRaw, pg8::OnePiece, g, S, E); publish_count(cnt + 1024 + 64 * xg); }
        if (jg == 0) { wait_count(cnt + 192, 44u, tmo);
            pg8::Gemm g{F.GB, F.W2D, M, DM, FF, FF, FF, 0}; pg8::OnePiece S{32, xg, zero, 44, one};
            pg8::EpiRes<false, true, true> E{nullptr, nullptr, F.HB, F.HB, F.ssq3, nullptr, 0.f, 0.5f, nullptr, nullptr, 0.f, (const float*)(ws + WS_SLAB), cnt + 1024 + 64 * xg, tmo};
            pg8::gemm_phase<pg8::EpiRes<false, true, true>, pg8::OnePiece>(F.lds + RING_OFF, g, S, E); publish_count(cnt + 256); }
        if (jg == 0) { wait_count(cnt + 256, 8u, tmo);
            pg8::Gemm g{F.HB, F.WPG, M, DM, DM, DM, DM, 0}; pg8::OneTile S{32, xg, DM / 64, one};
            EpiPleFinal E{H, F.HB, F.PROJ, F.ssq3, inv_d, F.ssq4, F.in[I_GFINAL], 2, cnt + 320, 8u, tmo, bar}; GEMM_CALL(EpiPleFinal, pg8::OneTile, g, S, E); }
        K5.r0 = 2; K5.r1 = 6; GEMM_CALL(pg8::EpiSwiGLU, pg8::SkewOrder, g5, K5, E5);
        if (BOTH(7)) SEAM();
    }
    if (IN(8)) {
        pg8::Gemm g{F.GB, F.W2D, M, DM, FF, FF, FF, 0}; pg8::StaticOrder S; S.init(MP, DM, FF, F.G, cdyn);
        pg8::EpiRes<false, true> E{nullptr, nullptr, F.HB, F.HB, F.ssq3, nullptr, 0.f, 0.5f, nullptr, nullptr, 0.f, nullptr, nullptr, nullptr};
        GEMM_CALL(PG8_COMMA(false, true), pg8::StaticOrder, g, S, E);
        if (BOTH(8)) SEAM();
    }
    if (IN(9)) {
        { pg8::Gemm gp{F.PB, F.WPP, M, DM, PLE, PLE, PLE, 0}; pg8::StaticOrder Sp; Sp.init(MP, DM, PLE, F.G, cdyn);
          pg8::EpiBf Ep{F.PROJ, DM, 0, nullptr}; GEMM_CALL(pg8::EpiBf, pg8::StaticOrder, gp, Sp, Ep); }
        pg8::Gemm g{F.HB, F.WPG, M, DM, DM, DM, DM, 0}; pg8::StaticOrder S; S.init(MP, DM, DM, F.G, cdyn);
        EpiPleFinal E{H, F.HB, F.PROJ, F.ssq3, inv_d, F.ssq4, F.in[I_GFINAL], local_ok ? 0 : 1, lcnt, 32u, tmo, bar}; GEMM_CALL(EpiPleFinal, pg8::StaticOrder, g, S, E);
    }
#undef IN
#undef BOTH
}

extern "C" void kernel_launch(void* const* d_in, const int* in_sizes, int n_in, void* d_out, int out_size, void* d_ws, size_t ws_size, hipStream_t stream) {
    static int grid = 0;
    if (grid == 0) {
        if (n_in != 25 || in_sizes[0] != MP * DM || (size_t)out_size != OUT_TOTAL || ws_size < WS_END) {
            fprintf(stderr, "kernel_launch: shape/workspace mismatch: n_in %d in0 %d out %d (want %zu) ws %zu (want %zu); nothing launched\n", n_in, n_in > 0 ? in_sizes[0] : -1, out_size, (size_t)OUT_TOTAL, ws_size, (size_t)WS_END); grid = -1; return; }
        int dev = 0, cus = 0, per_cu = 0;
        if (hipGetDevice(&dev) != hipSuccess || hipDeviceGetAttribute(&cus, hipDeviceAttributeMultiprocessorCount, dev) != hipSuccess) { fprintf(stderr, "kernel_launch: device query failed\n"); grid = -1; return; }
        if (hipFuncSetAttribute((const void*)hymba_fwd, hipFuncAttributeMaxDynamicSharedMemorySize, LDS_BYTES) != hipSuccess) { fprintf(stderr, "kernel_launch: hipFuncSetAttribute failed\n"); grid = -1; return; }
        if (hipOccupancyMaxActiveBlocksPerMultiprocessor(&per_cu, (const void*)hymba_fwd, NWAVES * 64, LDS_BYTES) != hipSuccess || per_cu < 1) { fprintf(stderr, "kernel_launch: occupancy query reports %d blocks per CU; nothing launched\n", per_cu); (void)hipGetLastError(); grid = -1; return; }
        if (cus != 256) { fprintf(stderr, "kernel_launch: the phase program deals tiles over 8 groups x 32 workgroups; this device has %d CUs; nothing launched\n", cus); grid = -1; return; }
        grid = cus;
    }
    if (grid < 0) return;
    if (hipMemsetAsync((char*)d_ws + WS_CTL, 0, CTL_ZERO_BYTES, stream) != hipSuccess) { fprintf(stderr, "kernel_launch: memset failed\n"); return; }
    Args a{};
    for (int i = 0; i < 25; ++i) a.in[i] = (const float*)d_in[i];
    a.out = (float*)d_out; a.ws = (unsigned char*)d_ws;
    if (N_LAUNCHES == 1) {
        a.ph_lo = 0; a.ph_hi = PER_PHASE;
        void* kargs[] = {&a};
        const hipError_t e = hipLaunchCooperativeKernel((const void*)hymba_fwd, dim3(grid), dim3(NWAVES * 64), kargs, LDS_BYTES, stream);
        if (e != hipSuccess) fprintf(stderr, "kernel_launch: cooperative launch failed: %s (grid %d)\n", hipGetErrorString(e), grid);
    } else {
        for (int li = 0; li < PER_PHASE; ++li) { a.ph_lo = li; a.ph_hi = li + 1;
            hipLaunchKernelGGL(hymba_fwd, dim3(grid), dim3(NWAVES * 64), LDS_BYTES, stream, a);
            const hipError_t le = hipPeekAtLastError(); if (le != hipSuccess) { fprintf(stderr, "kernel_launch: launch %d failed: %s\n", li, hipGetErrorName(le)); break; } }
    }
}
```
